# Optimizing an MI355X kernel written in HIP

```python
import jax
import jax.numpy as jnp
from jax import lax
import numpy as np

D_MODEL = 1024
BATCH = 2
SEQ = 16384
DEPTH = 4

N_MIXERS = 2
N_ATT_LAYERS = (DEPTH + 1) // N_MIXERS
N_HGRN_LAYERS = DEPTH // N_MIXERS
HEAD_DIM = 64
N_Q_HEADS = D_MODEL // HEAD_DIM
N_KV_HEADS = N_Q_HEADS // 4
GROUP = N_Q_HEADS // N_KV_HEADS
Q_DIM = N_Q_HEADS * HEAD_DIM
KV_DIM = N_KV_HEADS * HEAD_DIM
WINDOW = 128
ATT_BLOCK = 128
ROPE_DIM = HEAD_DIM // 4
ROPE_THETA = 500000.0
HGRN_EXPAND = 128
HGRN_HEADS = D_MODEL // HGRN_EXPAND
HGRN_KEY = HGRN_EXPAND
HGRN_VAL = D_MODEL // HGRN_HEADS
HGRN_KW = HGRN_HEADS * HGRN_KEY
HGRN_VW = HGRN_HEADS * HGRN_VAL
HGRN_IN_DIM = 3 * HGRN_KW + 2 * HGRN_VW
HGRN_CHUNK = 64
D_FF = -(-8 * D_MODEL // (3 * 256)) * 256
PLE_DIM = 256
ALPHA = (2 * DEPTH) ** 0.25
BETA = (8 * DEPTH) ** -0.25
LN_EPS = 1e-5

kernel_name = 'hybrid_swa_hgrn2_deepnorm_encoder'


def layer_norm(x, g, b):
    xf = x.astype(jnp.float32)
    mu = xf.mean(-1, keepdims=True)
    var = jnp.square(xf - mu).mean(-1, keepdims=True)
    y = (xf - mu) * lax.rsqrt(var + LN_EPS) * g.astype(jnp.float32) + b.astype(jnp.float32)
    return y.astype(x.dtype)


def rope_tables(seq):
    inv = ROPE_THETA ** (-jnp.arange(0, ROPE_DIM, 2, dtype=jnp.float32) / ROPE_DIM)
    ang = jnp.arange(seq, dtype=jnp.float32)[:, None] * inv[None, :]
    return jnp.cos(ang), jnp.sin(ang)


def apply_partial_rope(x, cos, sin):
    half = ROPE_DIM // 2
    c = cos[None, :, None, :]
    s = sin[None, :, None, :]
    xr = x[..., :ROPE_DIM].astype(jnp.float32)
    x1, x2 = xr[..., :half], xr[..., half:]
    rot = jnp.concatenate([x1 * c - x2 * s, x2 * c + x1 * s], axis=-1).astype(x.dtype)
    return jnp.concatenate([rot, x[..., ROPE_DIM:]], axis=-1)


def windowed_gqa(h, w_qkv, sink, w_o, cos, sin):
    B, S, _ = h.shape
    qkv = h @ w_qkv
    q = qkv[..., :Q_DIM].reshape(B, S, N_Q_HEADS, HEAD_DIM)
    k = qkv[..., Q_DIM:Q_DIM + KV_DIM].reshape(B, S, N_KV_HEADS, HEAD_DIM)
    v = qkv[..., Q_DIM + KV_DIM:].reshape(B, S, N_KV_HEADS, HEAD_DIM)
    q = apply_partial_rope(q, cos, sin).reshape(B, S, N_KV_HEADS, GROUP, HEAD_DIM)
    k = apply_partial_rope(k, cos, sin)
    pad = ((0, 0), (ATT_BLOCK, ATT_BLOCK), (0, 0), (0, 0))
    kp = jnp.pad(k, pad)
    vp = jnp.pad(v, pad)
    n_blocks = S // ATT_BLOCK
    scale = HEAD_DIM ** -0.5
    sink_f = sink.astype(jnp.float32).reshape(N_KV_HEADS, GROUP)[None, :, :, None, None]

    def block_attn(bi):
        start = bi * ATT_BLOCK
        qb = lax.dynamic_slice_in_dim(q, start, ATT_BLOCK, axis=1).astype(jnp.float32)
        kb = lax.dynamic_slice_in_dim(kp, start, 3 * ATT_BLOCK, axis=1).astype(jnp.float32)
        vb = lax.dynamic_slice_in_dim(vp, start, 3 * ATT_BLOCK, axis=1)
        s = jnp.einsum('bqhgd,bkhd->bhgqk', qb, kb) * scale
        qpos = start + jnp.arange(ATT_BLOCK)
        kpos = start - ATT_BLOCK + jnp.arange(3 * ATT_BLOCK)
        valid = (jnp.abs(qpos[:, None] - kpos[None, :]) <= WINDOW) & (kpos >= 0)[None, :] & (kpos < S)[None, :]
        s = jnp.where(valid, s, -jnp.inf)
        m = jnp.maximum(s.max(-1, keepdims=True), sink_f)
        pr = jnp.exp(s - m)
        den = pr.sum(-1, keepdims=True) + jnp.exp(sink_f - m)
        return jnp.einsum('bhgqk,bkhd->bqhgd', (pr / den).astype(vb.dtype), vb)

    o = lax.map(block_attn, jnp.arange(n_blocks))
    o = o.transpose(1, 0, 2, 3, 4, 5).reshape(B, S, Q_DIM)
    return o @ w_o


def gated_linear_scan(q, k, v, log_f):
    B, S, H, K = q.shape
    V = v.shape[-1]
    nc = S // HGRN_CHUNK

    def to_chunks(t):
        return t.reshape(B, nc, HGRN_CHUNK, H, t.shape[-1]).transpose(1, 0, 3, 2, 4)

    lower = jnp.tril(jnp.ones((HGRN_CHUNK, HGRN_CHUNK), dtype=bool))

    def step(state, inp):
        qc, kc, vc, gc = inp
        b = jnp.cumsum(gc, axis=2)
        inter = jnp.einsum('bhtk,bhkv->bhtv', qc * jnp.exp(b), state)
        diff = b[:, :, :, None, :] - b[:, :, None, :, :]
        decay = jnp.exp(jnp.where(lower[:, :, None], diff, -jnp.inf))
        scores = jnp.einsum('bhtk,bhsk,bhtsk->bhts', qc, kc, decay)
        intra = jnp.einsum('bhts,bhsv->bhtv', scores, vc)
        b_last = b[:, :, -1:, :]
        new_state = jnp.exp(b_last[:, :, 0, :])[..., None] * state + jnp.einsum('bhsk,bhsv->bhkv', kc * jnp.exp(b_last - b), vc)
        return new_state, inter + intra

    state0 = jnp.zeros((B, H, K, V), q.dtype)
    _, out = lax.scan(step, state0, (to_chunks(q), to_chunks(k), to_chunks(v), to_chunks(log_f)))
    return out.transpose(1, 0, 3, 2, 4).reshape(B, S, H, V)


def hgrn2_bidirectional(h, w_in, lb_fwd, lb_bwd, norm_g, w_o):
    B, S, _ = h.shape
    z = h @ w_in
    o1, o2, o3, o4 = HGRN_KW, 2 * HGRN_KW, 3 * HGRN_KW, 3 * HGRN_KW + HGRN_VW
    q = jax.nn.silu(z[..., :o1].astype(jnp.float32)).reshape(B, S, HGRN_HEADS, HGRN_KEY)
    v = z[..., o3:o4].astype(jnp.float32).reshape(B, S, HGRN_HEADS, HGRN_VAL)
    gate = z[..., o4:].astype(jnp.float32).reshape(B, S, HGRN_HEADS, HGRN_VAL)

    def forget(zf, lb):
        sig = jax.nn.sigmoid(zf.astype(jnp.float32))
        f = lb + (1.0 - lb) * sig
        k = (1.0 - lb) * (1.0 - sig)
        shape = (B, S, HGRN_HEADS, HGRN_KEY)
        return jnp.log(f).reshape(shape), k.reshape(shape)

    logf_f, k_f = forget(z[..., o1:o2], lb_fwd)
    logf_b, k_b = forget(z[..., o2:o3], lb_bwd)
    out_f = gated_linear_scan(q, k_f, v, logf_f)
    flip = lambda t: jnp.flip(t, axis=1)
    out_b = flip(gated_linear_scan(flip(q), flip(k_b), flip(v), flip(logf_b)))
    o = out_f + out_b
    o = o * lax.rsqrt(jnp.mean(o * o, axis=-1, keepdims=True) + LN_EPS) * norm_g.astype(jnp.float32)
    o = o * jax.nn.silu(gate)
    return o.reshape(B, S, HGRN_VW).astype(h.dtype) @ w_o


def swiglu(x, w_in, w_out):
    gu = x @ w_in
    g, u = jnp.split(gu, 2, axis=-1)
    return (jax.nn.silu(g) * u) @ w_out


def setup_inputs(seed: int = 0) -> dict:
    key = jax.random.key(seed)
    ks = jax.random.split(key, 17)
    f32 = jnp.float32
    D = D_MODEL

    def nrm(k, shape, scale):
        return jax.random.normal(k, shape, f32) * scale

    return {
        'x': nrm(ks[0], (BATCH, SEQ, D), 1.0),
        'p': nrm(ks[1], (DEPTH, BATCH, SEQ, PLE_DIM), 1.0),
        'att_w_qkv': nrm(ks[2], (N_ATT_LAYERS, D, Q_DIM + 2 * KV_DIM), D ** -0.5),
        'att_sink': nrm(ks[3], (N_ATT_LAYERS, N_Q_HEADS), 0.5),
        'att_w_o': nrm(ks[4], (N_ATT_LAYERS, Q_DIM, D), BETA * Q_DIM ** -0.5),
        'hgrn_w_in': nrm(ks[5], (N_HGRN_LAYERS, D, HGRN_IN_DIM), D ** -0.5),
        'hgrn_lb_logits': nrm(ks[6], (DEPTH, 2, HGRN_KW), 0.1),
        'hgrn_norm_g': 1.0 + nrm(ks[7], (N_HGRN_LAYERS, HGRN_VAL), 0.01),
        'hgrn_w_o': nrm(ks[8], (N_HGRN_LAYERS, HGRN_VW, D), BETA * HGRN_VW ** -0.5),
        'ln_mix_g': 1.0 + nrm(ks[9], (DEPTH, D), 0.01),
        'ln_mix_b': nrm(ks[10], (DEPTH, D), 0.01),
        'ffn_w_in': nrm(ks[11], (DEPTH, D, 2 * D_FF), D ** -0.5),
        'ffn_w_out': nrm(ks[12], (DEPTH, D_FF, D), BETA * D_FF ** -0.5),
        'ln_ffn_g': 1.0 + nrm(ks[13], (DEPTH, D), 0.01),
        'ln_ffn_b': nrm(ks[14], (DEPTH, D), 0.01),
        'ple_w_gate': nrm(ks[15], (DEPTH, D, D), D ** -0.5),
        'ple_w_proj': nrm(ks[16], (DEPTH, PLE_DIM, D), BETA * PLE_DIM ** -0.5),
    }


def reference(x, p, att_w_qkv, att_sink, att_w_o, hgrn_w_in, hgrn_lb_logits, hgrn_norm_g, hgrn_w_o,
              ln_mix_g, ln_mix_b, ffn_w_in, ffn_w_out, ln_ffn_g, ln_ffn_b, ple_w_gate, ple_w_proj):
    S = x.shape[1]
    cos, sin = rope_tables(S)
    lb_sm = jax.nn.softmax(hgrn_lb_logits.astype(jnp.float32), axis=0)
    lb_all = jnp.cumsum(lb_sm, axis=0) - lb_sm[0:1]
    for i in range(DEPTH):
        j = i // N_MIXERS
        if i % N_MIXERS == 0:
            mix = windowed_gqa(x, att_w_qkv[j], att_sink[j], att_w_o[j], cos, sin)
        else:
            mix = hgrn2_bidirectional(x, hgrn_w_in[j], lb_all[i, 0], lb_all[i, 1], hgrn_norm_g[j], hgrn_w_o[j])
        x = layer_norm(ALPHA * x + mix, ln_mix_g[i], ln_mix_b[i])
        x = layer_norm(ALPHA * x + swiglu(x, ffn_w_in[i], ffn_w_out[i]), ln_ffn_g[i], ln_ffn_b[i])
        x = x + jax.nn.sigmoid(x @ ple_w_gate[i]) * (p[i] @ ple_w_proj[i])
    return x
```

```cpp
#include <hip/hip_runtime.h>
#include <hip/hip_cooperative_groups.h>
#include <cstdio>
#include <cstdint>
namespace cg = cooperative_groups;
namespace pg8 {
#define PG8_LAS __attribute__((address_space(3)))
typedef unsigned short bf16_t;
typedef short bf16x8 __attribute__((ext_vector_type(8)));
typedef float f32x4 __attribute__((ext_vector_type(4)));
typedef unsigned u32x4 __attribute__((ext_vector_type(4)));
constexpr int BM = 256, BK = 64, HALF = 128, HTB = HALF * BK * 2  , STAGE_BYTES = 8 * HTB, NXCD = 8, WGM = 8;

__host__ __device__ __forceinline__ int lds_byte(int r, int c) { const int st = (r >> 4) * 2 + (c >> 5), rr = r & 15, cc = c & 31, ob = rr * 64 + cc * 2; return st * 1024 + (ob ^ (((ob >> 9) & 1) << 5)); }
__host__ __device__ __forceinline__ void stage_rc(int b, int& R, int& C) { const int st = b / 1024, sb = b % 1024, swz = sb ^ (((sb >> 9) & 1) << 5); R = (st >> 1) * 16 + swz / 64; C = (st & 1) * 32 + (swz % 64) / 2; }
__host__ __device__ __forceinline__ int perm32(int rho) { const int n = rho >> 4, i = rho & 15; return 8 * (i >> 2) + 4 * n + (i & 3); }

struct Unit { int pm, pn; };
struct Gemm { const bf16_t* A; const bf16_t* Bt; int M, N, K, lda, ldb; };

struct StaticOrder {
    int nM, nN, nwg, G, c;
    __host__ __device__ void init(int M, int N, int G_, int c_) { nM = M / BM; nN = N / BM; nwg = nM * nN; G = G_; c = c_; }
    __host__ __device__ bool next(int i, Unit& u) const {
        const long L = (long)i * G + c; if (L >= nwg) return false;
        int wgid = (int)L; { const int q = nwg / NXCD, r = nwg % NXCD, xcd = wgid % NXCD, off = wgid / NXCD; wgid = (xcd < r ? xcd * (q + 1) : r * (q + 1) + (xcd - r) * q) + off; }
        const int nig = WGM * nN, gid = wgid / nig, fm = gid * WGM, gsz = (nM - fm) < WGM ? (nM - fm) : WGM;
        u.pm = fm + ((wgid % nig) % gsz); u.pn = (wgid % nig) / gsz; return true;
    }
    __device__ __forceinline__ void a_ready(const Unit&) const {}
    __device__ __forceinline__ void done(const Unit&) const {}
};

__device__ __forceinline__ unsigned cvt_pk_bf16(float lo, float hi) { unsigned r; asm volatile("v_cvt_pk_bf16_f32 %0, %1, %2" : "=v"(r) : "v"(lo), "v"(hi)); return r; }
template <class Epi, class Sched, bool ALIGN_EPI = false, bool SP2 = false>
__device__ __forceinline__ void gemm_phase(PG8_LAS unsigned char* lds, const Gemm g, const Sched& S, const Epi& E) {
    int tid_l = threadIdx.x; asm volatile("" : "+v"(tid_l));
    const int tid = tid_l, wid = __builtin_amdgcn_readfirstlane(tid >> 6), lane = tid & 63, wr = wid >> 2, wc = wid & 3, fr = lane & 15, fq = lane >> 4;
    const int K = g.K, nt = K / BK;
    unsigned voffA[2], voffB[2];
#pragma unroll
    for (int i = 0; i < 2; ++i) { int R, C; stage_rc(tid * 16 + i * 8192, R, C); const int Rb = Epi::PERM ? ((R & ~31) + perm32(R & 31)) : R;
        voffA[i] = (unsigned)(R * g.lda + C) * 2u; voffB[i] = (unsigned)(Rb * g.ldb + C) * 2u; }
    const size_t kstep = (size_t)(BK * 2);
    const size_t hstepA = (size_t)HALF * g.lda * 2, hstepB = (size_t)HALF * g.ldb * 2;
    const size_t tstepA = 2 * hstepA, tstepB = 2 * hstepB;
    const unsigned ldsw = (unsigned)wid * 1024u;
    const int aoff = lds_byte(wr * 64 + fr, fq * 8), boff = lds_byte(wc * 32 + fr, fq * 8);
#define PG8_SA(b, h) (((b) * 2 + (h)) * HTB)
#define PG8_SB(b, h) ((4 + (b) * 2 + (h)) * HTB)
#define PG8_STAGE(bufoff, gbase, voff) do { _Pragma("unroll") for (int _i = 0; _i < 2; ++_i) \
        __builtin_amdgcn_global_load_lds((const unsigned*)((const char*)(gbase) + (voff)[_i]), (PG8_LAS unsigned*)(lds + (bufoff) + ldsw + _i * 8192), 16, 0, 0); } while (0)
#define PG8_LDA(dst, b, h) do { _Pragma("unroll") for (int m = 0; m < 4; ++m) _Pragma("unroll") for (int k = 0; k < 2; ++k) dst[m][k] = *(const PG8_LAS bf16x8*)(lds + PG8_SA(b, h) + aoff + m * 2048 + k * 1024); } while (0)
#define PG8_LDB(dst, b, h) do { _Pragma("unroll") for (int n = 0; n < 2; ++n) _Pragma("unroll") for (int k = 0; k < 2; ++k) dst[n][k] = *(const PG8_LAS bf16x8*)(lds + PG8_SB(b, h) + boff + n * 2048 + k * 1024); } while (0)
#define PG8_MMA(ai, bj, At, Bt) do { __builtin_amdgcn_s_setprio(1); _Pragma("unroll") for (int m = 0; m < 4; ++m) _Pragma("unroll") for (int n = 0; n < 2; ++n) _Pragma("unroll") for (int k = 0; k < 2; ++k) \
        acc[ai][bj][m][n] = __builtin_amdgcn_mfma_f32_16x16x32_bf16(Bt[n][k], At[m][k], acc[ai][bj][m][n], 0, 0, 0); __builtin_amdgcn_s_setprio(0); } while (0)
#define PG8_WAIT_V(n) asm volatile("s_waitcnt vmcnt(" #n ")" ::: "memory")
#define PG8_WAIT_L(n) asm volatile("s_waitcnt lgkmcnt(" #n ")" ::: "memory")
#define PG8_BAR __builtin_amdgcn_s_barrier()
#define PG8_SCHED __builtin_amdgcn_sched_barrier(0)
    Unit cur, nxt; int ui = 0;
    if (!S.next(0, cur)) return;
    f32x4 acc[2][2][4][2];
#pragma unroll
    for (int a = 0; a < 2; ++a)
#pragma unroll
        for (int b = 0; b < 2; ++b)
#pragma unroll
            for (int m = 0; m < 4; ++m)
#pragma unroll
                for (int n = 0; n < 2; ++n) acc[a][b][m][n] = (f32x4){0.f, 0.f, 0.f, 0.f};
    bf16x8 At[4][2], B0[2][2], B1[2][2];
    const char* cA = (const char*)g.A + (size_t)cur.pm * tstepA; const char* cB = (const char*)g.Bt + (size_t)cur.pn * tstepB;
    S.a_ready(cur);
    if constexpr (SP2) {
        PG8_STAGE(PG8_SB(0, 0), cB, voffB); PG8_STAGE(PG8_SB(0, 1), cB + hstepB, voffB); PG8_STAGE(PG8_SA(0, 0), cA, voffA); PG8_STAGE(PG8_SA(0, 1), cA + hstepA, voffA);
        if (wr == 1) PG8_BAR;
        PG8_WAIT_V(2); PG8_BAR;
        PG8_STAGE(PG8_SB(1, 0), cB + kstep, voffB); PG8_STAGE(PG8_SA(1, 0), cA + kstep, voffA); PG8_STAGE(PG8_SB(1, 1), cB + hstepB + kstep, voffB);
        PG8_WAIT_V(6); PG8_BAR;
    } else {
        PG8_STAGE(PG8_SB(0, 0), cB, voffB); PG8_STAGE(PG8_SA(0, 0), cA, voffA); PG8_STAGE(PG8_SB(0, 1), cB + hstepB, voffB); PG8_STAGE(PG8_SA(0, 1), cA + hstepA, voffA);
        if (wr == 1) PG8_BAR;
        PG8_WAIT_V(4); PG8_BAR;
        PG8_STAGE(PG8_SB(1, 0), cB + kstep, voffB); PG8_STAGE(PG8_SA(1, 0), cA + kstep, voffA); PG8_STAGE(PG8_SB(1, 1), cB + hstepB + kstep, voffB);
        PG8_WAIT_V(6); PG8_BAR;
    }
    for (;;) {
        const bool has_next = S.next(ui + 1, nxt);
        const char* nA = has_next ? (const char*)g.A + (size_t)nxt.pm * tstepA : cA; const char* nB = has_next ? (const char*)g.Bt + (size_t)nxt.pn * tstepB : cB;
        for (int t = 0; t < nt; t += 2) {
            const bool last = (t == nt - 2);
            const char* a1 = cA + (size_t)(t + 1) * kstep;
            const char* a2 = last ? nA : cA + (size_t)(t + 2) * kstep; const char* b2 = last ? nB : cB + (size_t)(t + 2) * kstep;
            const char* a3 = a2 + kstep; const char* b3 = b2 + kstep;
            if (last && has_next) S.a_ready(nxt);
            if constexpr (SP2) {
            PG8_LDB(B0, 0, 0); PG8_LDB(B1, 0, 1); PG8_SCHED; PG8_LDA(At, 0, 0); PG8_STAGE(PG8_SA(1, 1), a1 + hstepA, voffA);
            PG8_WAIT_V(8); PG8_WAIT_L(0); PG8_BAR; PG8_MMA(0, 0, At, B0); PG8_MMA(0, 1, At, B1); PG8_BAR; PG8_SCHED;
            PG8_LDA(At, 0, 1); PG8_STAGE(PG8_SB(0, 0), b2, voffB); PG8_STAGE(PG8_SB(0, 1), b2 + hstepB, voffB); PG8_STAGE(PG8_SA(0, 0), a2, voffA);
            PG8_WAIT_V(8); PG8_WAIT_L(0); PG8_BAR; PG8_MMA(1, 0, At, B0); PG8_MMA(1, 1, At, B1); PG8_BAR; PG8_SCHED;
            PG8_LDB(B0, 1, 0); PG8_LDB(B1, 1, 1); PG8_SCHED; PG8_LDA(At, 1, 0); PG8_STAGE(PG8_SA(0, 1), a2 + hstepA, voffA);
            PG8_WAIT_V(8); PG8_WAIT_L(0); PG8_BAR; PG8_MMA(0, 0, At, B0); PG8_MMA(0, 1, At, B1); PG8_BAR; PG8_SCHED;
            PG8_LDA(At, 1, 1); PG8_STAGE(PG8_SB(1, 0), b3, voffB); PG8_STAGE(PG8_SB(1, 1), b3 + hstepB, voffB); PG8_STAGE(PG8_SA(1, 0), a3, voffA);
            PG8_WAIT_V(8); PG8_WAIT_L(0); PG8_BAR; PG8_MMA(1, 0, At, B0); PG8_MMA(1, 1, At, B1); PG8_BAR; PG8_SCHED;
            } else {
            PG8_LDB(B0, 0, 0); PG8_SCHED; PG8_LDA(At, 0, 0); PG8_STAGE(PG8_SA(1, 1), a1 + hstepA, voffA);
            PG8_WAIT_L(8); PG8_BAR; PG8_WAIT_L(0); PG8_MMA(0, 0, At, B0); PG8_BAR; PG8_SCHED;
            PG8_LDB(B1, 0, 1); PG8_STAGE(PG8_SB(0, 0), b2, voffB);
            PG8_BAR; PG8_WAIT_L(0); PG8_MMA(0, 1, At, B1); PG8_BAR;
            PG8_LDA(At, 0, 1); PG8_STAGE(PG8_SA(0, 0), a2, voffA);
            PG8_BAR; PG8_WAIT_L(0); PG8_MMA(1, 0, At, B0); PG8_BAR; PG8_SCHED;
            PG8_STAGE(PG8_SB(0, 1), b2 + hstepB, voffB);
            PG8_WAIT_V(6); PG8_BAR; PG8_MMA(1, 1, At, B1); PG8_BAR;
            PG8_LDB(B0, 1, 0); PG8_SCHED; PG8_LDA(At, 1, 0); PG8_STAGE(PG8_SA(0, 1), a2 + hstepA, voffA);
            PG8_WAIT_L(8); PG8_BAR; PG8_WAIT_L(0); PG8_MMA(0, 0, At, B0); PG8_BAR; PG8_SCHED;
            PG8_LDB(B1, 1, 1); PG8_STAGE(PG8_SB(1, 0), b3, voffB);
            PG8_BAR; PG8_WAIT_L(0); PG8_MMA(0, 1, At, B1); PG8_BAR;
            PG8_LDA(At, 1, 1); PG8_STAGE(PG8_SA(1, 0), a3, voffA);
            PG8_BAR; PG8_WAIT_L(0); PG8_MMA(1, 0, At, B0); PG8_BAR; PG8_SCHED;
            PG8_STAGE(PG8_SB(1, 1), b3 + hstepB, voffB);
            PG8_WAIT_V(6); PG8_BAR; PG8_MMA(1, 1, At, B1); PG8_BAR;
            }
        }
        if constexpr (ALIGN_EPI) { if (wr == 0) PG8_BAR; }
        if constexpr (!Epi::AFTER_DRAIN) { E(acc, cur, wr, wc, fr, fq); S.done(cur); }
        if (!has_next) break;
#pragma unroll
        for (int a = 0; a < 2; ++a)
#pragma unroll
            for (int b = 0; b < 2; ++b)
#pragma unroll
                for (int m = 0; m < 4; ++m)
#pragma unroll
                    for (int n = 0; n < 2; ++n) acc[a][b][m][n] = (f32x4){0.f, 0.f, 0.f, 0.f};
        cur = nxt; cA = nA; cB = nB; ++ui;
        if constexpr (ALIGN_EPI) { if (wr == 1) PG8_BAR; }
    }
    PG8_WAIT_V(0);
    if constexpr (!ALIGN_EPI) { if (wr == 0) PG8_BAR; }
    PG8_BAR;
    if constexpr (Epi::AFTER_DRAIN) { E.fused(acc, cur, wr, wc, fr, fq, lds, wid, lane); S.done(cur); }
#undef PG8_SA
#undef PG8_SB
#undef PG8_STAGE
#undef PG8_LDA
#undef PG8_LDB
#undef PG8_MMA
#undef PG8_WAIT_V
#undef PG8_WAIT_L
#undef PG8_BAR
#undef PG8_SCHED
}
}

using pg8::bf16_t; using pg8::bf16x8; using pg8::f32x4; using pg8::u32x4; using pg8::Unit; using pg8::cvt_pk_bf16;
typedef unsigned u32x2 __attribute__((ext_vector_type(2)));
typedef float f32x2 __attribute__((ext_vector_type(2)));
typedef float f32x16 __attribute__((ext_vector_type(16)));

constexpr int BATCH = 2, SEQ = 16384, D = 1024, M = BATCH * SEQ, DFF = 2816, PLE = 256, DEPTH = 4;
constexpr int NQKV = 1536, HIN = 5120;
constexpr float ALPHA = 1.681792830507429f, LN_EPS = 1e-5f, LOG2E = 1.4426950408889634f;
constexpr size_t MiB = (size_t)1 << 20;
constexpr size_t WS_WIN = 0, WS_WOUT = 10 * MiB, WS_W1 = 12 * MiB, WS_W2 = 23 * MiB, WS_WG = 29 * MiB, WS_WP = 31 * MiB, WS_VEC = 31 * MiB + 512 * 1024;
constexpr size_t WS_ST1 = 32 * MiB, WS_ST2 = 36 * MiB, WS_XBX = 40 * MiB, WS_XBY = 104 * MiB, WS_PP = 168 * MiB;
constexpr size_t WS_Q = 248 * MiB, WS_K = 312 * MiB, WS_V = 328 * MiB, WS_O = 344 * MiB, WS_H = 248 * MiB;
constexpr size_t WS_Z = 104 * MiB, WS_SB = 424 * MiB, WS_SF = WS_XBX, WS_PB = 488 * MiB, WS_ROPE = 504 * MiB, WS_LB = 505 * MiB, WS_DEC = 506 * MiB, WS_END = 508 * MiB;
constexpr int LDS_BYTES = 147456;

__device__ __forceinline__ float bf_lo(unsigned w) { return __uint_as_float(w << 16); }
__device__ __forceinline__ float bf_hi(unsigned w) { return __uint_as_float(w & 0xffff0000u); }
__device__ __forceinline__ unsigned f2bf(float f) { unsigned u = __float_as_uint(f); return (u + 0x7fffu + ((u >> 16) & 1u)) >> 16; }
__device__ __forceinline__ float sigmoidf_(float x) { return 1.0f / (1.0f + __expf(-x)); }
__device__ __forceinline__ u32x4 pack8(const f32x4 a, const f32x4 b) { u32x4 w; w.x = cvt_pk_bf16(a[0], a[1]); w.y = cvt_pk_bf16(a[2], a[3]); w.z = cvt_pk_bf16(b[0], b[1]); w.w = cvt_pk_bf16(b[2], b[3]); return w; }

__device__ __forceinline__ void load_row_stats(const f32x2* part, int pm, int wr, int fr, int fq, float (&mu)[8], float (&rs)[8]) {
    float mye[2], rse[2];
#pragma unroll
    for (int e = 0; e < 2; ++e) {
        const int row = pm * 256 + (fq >> 1) * 128 + wr * 64 + (2 * (fq & 1) + e) * 16 + fr;
        const f32x4* p = (const f32x4*)(part + (size_t)row * 16);
        float s = 0.f, q = 0.f;
#pragma unroll
        for (int i = 0; i < 8; ++i) { const f32x4 v = p[i]; s += v[0] + v[2]; q += v[1] + v[3]; }
        const float mean = s * (1.0f / 1024.0f); float var = q * (1.0f / 1024.0f) - mean * mean; var = var > 0.f ? var : 0.f;
        mye[e] = mean; rse[e] = 1.0f / sqrtf(var + LN_EPS);
    }
#pragma unroll
    for (int ai = 0; ai < 2; ++ai)
#pragma unroll
        for (int m = 0; m < 4; ++m) { const int src = fr + 16 * (ai * 2 + (m >> 1)); mu[ai * 4 + m] = __shfl(mye[m & 1], src); rs[ai * 4 + m] = __shfl(rse[m & 1], src); }
}

struct EpiPlain {
    static constexpr bool PERM = true, AFTER_DRAIN = false;
    bf16_t* O; int ldc;
    __device__ __forceinline__ void operator()(const f32x4 (&acc)[2][2][4][2], const Unit& u, int wr, int wc, int fr, int fq) const {
        const int row0 = u.pm * 256 + wr * 64 + fr, col0 = u.pn * 256 + wc * 32 + 8 * fq;
#pragma unroll
        for (int ai = 0; ai < 2; ++ai)
#pragma unroll
            for (int m = 0; m < 4; ++m) { bf16_t* rowp = O + (size_t)(row0 + ai * 128 + m * 16) * ldc + col0;
#pragma unroll
                for (int bj = 0; bj < 2; ++bj) *(u32x4*)(rowp + bj * 128) = pack8(acc[ai][bj][m][0], acc[ai][bj][m][1]); }
    }
};

struct EpiQKV {
    static constexpr bool PERM = true, AFTER_DRAIN = false;
    bf16_t *Q, *K, *V; const float* rope;
    __device__ __forceinline__ void operator()(const f32x4 (&acc)[2][2][4][2], const Unit& u, int wr, int wc, int fr, int fq) const {
        bf16_t* base; int ldc, colt; float sc;
        if (u.pn < 4) { base = Q; ldc = 1024; colt = u.pn * 256; sc = 0.125f * LOG2E; } else if (u.pn == 4) { base = K; ldc = 256; colt = 0; sc = 1.f; } else { base = V; ldc = 256; colt = 0; sc = 1.f; }
        const bool do_rope = (u.pn < 5) && ((wc & 1) == 0) && (fq < 2);
        const int col0 = colt + wc * 32 + 8 * fq;
#pragma unroll
        for (int ai = 0; ai < 2; ++ai)
#pragma unroll
            for (int m = 0; m < 4; ++m) {
                const int row = u.pm * 256 + ai * 128 + wr * 64 + m * 16 + fr, pos = row & (SEQ - 1);
                f32x4 c4 = {1.f, 1.f, 1.f, 1.f}, s4 = {0.f, 0.f, 0.f, 0.f};
                if (do_rope) { c4 = *(const f32x4*)(rope + (size_t)pos * 8 + 4 * fq); s4 = *(const f32x4*)(rope + (size_t)SEQ * 8 + (size_t)pos * 8 + 4 * fq); }
#pragma unroll
                for (int bj = 0; bj < 2; ++bj) {
                    f32x4 v0 = acc[ai][bj][m][0], v1 = acc[ai][bj][m][1];
                    if (do_rope) {
                        f32x4 r0, r1;
                        r0[0] = v0[0] * c4[0] - v0[1] * s4[0]; r0[1] = v0[1] * c4[0] + v0[0] * s4[0];
                        r0[2] = v0[2] * c4[1] - v0[3] * s4[1]; r0[3] = v0[3] * c4[1] + v0[2] * s4[1];
                        r1[0] = v1[0] * c4[2] - v1[1] * s4[2]; r1[1] = v1[1] * c4[2] + v1[0] * s4[2];
                        r1[2] = v1[2] * c4[3] - v1[3] * s4[3]; r1[3] = v1[3] * c4[3] + v1[2] * s4[3];
                        v0 = r0; v1 = r1;
                    }
                    v0 = v0 * sc; v1 = v1 * sc;
                    *(u32x4*)(base + (size_t)row * ldc + col0 + bj * 128) = pack8(v0, v1);
                }
            }
    }
};

struct EpiHin {
    static constexpr bool PERM = true, AFTER_DRAIN = false;
    bf16_t* Z; const float* lb;
    __device__ __forceinline__ void operator()(const f32x4 (&acc)[2][2][4][2], const Unit& u, int wr, int wc, int fr, int fq) const {
        const int seg = u.pn >> 2, col0 = u.pn * 256 + wc * 32 + 8 * fq;
#pragma unroll
        for (int bj = 0; bj < 2; ++bj) {
            f32x4 l0 = {0.f, 0.f, 0.f, 0.f}, l1 = l0;
            if (seg == 1 || seg == 2) { const float* lp = lb + (col0 + bj * 128 - 1024); l0 = *(const f32x4*)lp; l1 = *(const f32x4*)(lp + 4); }
#pragma unroll
            for (int ai = 0; ai < 2; ++ai)
#pragma unroll
                for (int m = 0; m < 4; ++m) {
                    const int row = u.pm * 256 + ai * 128 + wr * 64 + m * 16 + fr;
                    f32x4 v0 = acc[ai][bj][m][0], v1 = acc[ai][bj][m][1];
                    if (seg == 0 || seg == 4) {
#pragma unroll
                        for (int i = 0; i < 4; ++i) { v0[i] = v0[i] * sigmoidf_(v0[i]); v1[i] = v1[i] * sigmoidf_(v1[i]); }
                    } else if (seg == 1 || seg == 2) {
#pragma unroll
                        for (int i = 0; i < 4; ++i) { v0[i] = __logf(l0[i] + (1.f - l0[i]) * sigmoidf_(v0[i])); v1[i] = __logf(l1[i] + (1.f - l1[i]) * sigmoidf_(v1[i])); }
                    }
                    *(u32x4*)(Z + (size_t)row * HIN + col0 + bj * 128) = pack8(v0, v1);
                }
        }
    }
};

template <bool LNRES> struct EpiRes {
    static constexpr bool PERM = true, AFTER_DRAIN = false;
    const float* resid; float* out; bf16_t* xb; f32x2* part_out; const f32x2* part_in; const float* g; const float* b;
    __device__ __forceinline__ void operator()(const f32x4 (&acc)[2][2][4][2], const Unit& u, int wr, int wc, int fr, int fq) const {
        float mu[8], rs[8];
        if (LNRES) load_row_stats(part_in, u.pm, wr, fr, fq, mu, rs);
        const int col0 = u.pn * 256 + wc * 32 + 8 * fq;
        float ss[8], qq[8];
#pragma unroll
        for (int i = 0; i < 8; ++i) { ss[i] = 0.f; qq[i] = 0.f; }
#pragma unroll
        for (int bj = 0; bj < 2; ++bj) {
            f32x4 g0, g1, b0, b1;
            if (LNRES) { g0 = *(const f32x4*)(g + col0 + bj * 128); g1 = *(const f32x4*)(g + col0 + bj * 128 + 4); b0 = *(const f32x4*)(b + col0 + bj * 128); b1 = *(const f32x4*)(b + col0 + bj * 128 + 4); }
#pragma unroll
            for (int ai = 0; ai < 2; ++ai)
#pragma unroll
                for (int m = 0; m < 4; ++m) {
                    const int row = u.pm * 256 + ai * 128 + wr * 64 + m * 16 + fr; const size_t off = (size_t)row * D + col0 + bj * 128;
                    f32x4 r0 = *(const f32x4*)(resid + off), r1 = *(const f32x4*)(resid + off + 4);
                    if (LNRES) { const float mm = mu[ai * 4 + m], rr = rs[ai * 4 + m]; r0 = (r0 - mm) * rr * g0 + b0; r1 = (r1 - mm) * rr * g1 + b1; }
                    const f32x4 y0 = r0 * ALPHA + acc[ai][bj][m][0], y1 = r1 * ALPHA + acc[ai][bj][m][1];
                    *(f32x4*)(out + off) = y0; *(f32x4*)(out + off + 4) = y1;
                    *(u32x4*)(xb + off) = pack8(y0, y1);
                    ss[ai * 4 + m] += (y0[0] + y0[1]) + (y0[2] + y0[3]) + (y1[0] + y1[1]) + (y1[2] + y1[3]);
                    qq[ai * 4 + m] += (y0[0] * y0[0] + y0[1] * y0[1]) + (y0[2] * y0[2] + y0[3] * y0[3]) + (y1[0] * y1[0] + y1[1] * y1[1]) + (y1[2] * y1[2] + y1[3] * y1[3]);
                }
        }
#pragma unroll
        for (int ai = 0; ai < 2; ++ai)
#pragma unroll
            for (int m = 0; m < 4; ++m) {
                float s = ss[ai * 4 + m], q = qq[ai * 4 + m];
                s += __shfl_xor(s, 16); s += __shfl_xor(s, 32); q += __shfl_xor(q, 16); q += __shfl_xor(q, 32);
                const int row = u.pm * 256 + ai * 128 + wr * 64 + m * 16 + fr;
                if (fq == 0) part_out[(size_t)row * 16 + u.pn * 4 + wc] = (f32x2){s, q};
            }
    }
};

struct EpiFfn1 {
    static constexpr bool PERM = true, AFTER_DRAIN = false;
    bf16_t* H; const f32x2* part; const float* cs; const float* bw;
    __device__ __forceinline__ void operator()(const f32x4 (&acc)[2][2][4][2], const Unit& u, int wr, int wc, int fr, int fq) const {
        float mu[8], rs[8];
        load_row_stats(part, u.pm, wr, fr, fq, mu, rs);
        const int col0 = u.pn * 256 + wc * 32 + 8 * fq, hcol0 = u.pn * 128 + wc * 16 + 4 * fq;
#pragma unroll
        for (int bj = 0; bj < 2; ++bj) {
            const f32x4 c0 = *(const f32x4*)(cs + col0 + bj * 128), c1 = *(const f32x4*)(cs + col0 + bj * 128 + 4), w0 = *(const f32x4*)(bw + col0 + bj * 128), w1 = *(const f32x4*)(bw + col0 + bj * 128 + 4);
#pragma unroll
            for (int ai = 0; ai < 2; ++ai)
#pragma unroll
                for (int m = 0; m < 4; ++m) {
                    const int row = u.pm * 256 + ai * 128 + wr * 64 + m * 16 + fr; const float mm = mu[ai * 4 + m], rr = rs[ai * 4 + m];
                    const f32x4 v0 = (acc[ai][bj][m][0] - c0 * mm) * rr + w0, v1 = (acc[ai][bj][m][1] - c1 * mm) * rr + w1;
                    const float h0 = v0[0] * sigmoidf_(v0[0]) * v0[1], h1 = v0[2] * sigmoidf_(v0[2]) * v0[3], h2 = v1[0] * sigmoidf_(v1[0]) * v1[1], h3 = v1[2] * sigmoidf_(v1[2]) * v1[3];
                    u32x2 w; w.x = cvt_pk_bf16(h0, h1); w.y = cvt_pk_bf16(h2, h3);
                    *(u32x2*)(H + (size_t)row * DFF + hcol0 + bj * 64) = w;
                }
        }
    }
};

struct EpiPle {
    static constexpr bool PERM = true, AFTER_DRAIN = false;
    float* out; bf16_t* xb; const f32x2* part; const float *g, *b, *cs, *bw; const bf16_t* pp;
    __device__ __forceinline__ void operator()(const f32x4 (&acc)[2][2][4][2], const Unit& u, int wr, int wc, int fr, int fq) const {
        float mu[8], rs[8];
        load_row_stats(part, u.pm, wr, fr, fq, mu, rs);
        const int col0 = u.pn * 256 + wc * 32 + 8 * fq;
#pragma unroll
        for (int bj = 0; bj < 2; ++bj) {
            const int cc = col0 + bj * 128;
            const f32x4 g0 = *(const f32x4*)(g + cc), g1 = *(const f32x4*)(g + cc + 4), b0 = *(const f32x4*)(b + cc), b1 = *(const f32x4*)(b + cc + 4);
            const f32x4 c0 = *(const f32x4*)(cs + cc), c1 = *(const f32x4*)(cs + cc + 4), w0 = *(const f32x4*)(bw + cc), w1 = *(const f32x4*)(bw + cc + 4);
#pragma unroll
            for (int ai = 0; ai < 2; ++ai)
#pragma unroll
                for (int m = 0; m < 4; ++m) {
                    const int row = u.pm * 256 + ai * 128 + wr * 64 + m * 16 + fr; const size_t off = (size_t)row * D + cc; const float mm = mu[ai * 4 + m], rr = rs[ai * 4 + m];
                    const f32x4 y0 = *(const f32x4*)(out + off), y1 = *(const f32x4*)(out + off + 4);
                    const u32x4 pw = *(const u32x4*)(pp + off);
                    const f32x4 p0 = {bf_lo(pw.x), bf_hi(pw.x), bf_lo(pw.y), bf_hi(pw.y)}, p1 = {bf_lo(pw.z), bf_hi(pw.z), bf_lo(pw.w), bf_hi(pw.w)};
                    f32x4 t0 = (acc[ai][bj][m][0] - c0 * mm) * rr + w0, t1 = (acc[ai][bj][m][1] - c1 * mm) * rr + w1;
#pragma unroll
                    for (int i = 0; i < 4; ++i) { t0[i] = sigmoidf_(t0[i]); t1[i] = sigmoidf_(t1[i]); }
                    const f32x4 x0 = (y0 - mm) * rr * g0 + b0 + t0 * p0, x1 = (y1 - mm) * rr * g1 + b1 + t1 * p1;
                    *(f32x4*)(out + off) = x0; *(f32x4*)(out + off + 4) = x1;
                    *(u32x4*)(xb + off) = pack8(x0, x1);
                }
        }
    }
};

template <int MODE, bool FOLD>
__device__ __forceinline__ void conv_item(const float* W, int K, int N, bf16_t* Bt, int n0, int k0, int klen, const float* g, const float* bvec, float* cs, float* bw, float* scr, int lane) {
    const int np = n0 + (lane & 31); int src = np;
    if (MODE == 1) { if (np < 1280) { const int hp = np & 63; if (hp < 16) src = (np & ~63) + (hp >> 1) + 8 * (hp & 1); } }
    if (MODE == 2) { const int t = np >> 8, w = np & 255; src = (w & 1) * DFF + t * 128 + (w >> 1); }
    float csacc = 0.f, bacc = 0.f;
    for (int ks = k0; ks < k0 + klen; ks += 64) {
#pragma unroll 8
        for (int i = 0; i < 32; ++i) {
            const int kk = 2 * i + (lane >> 5);
            float w = W[(size_t)(ks + kk) * N + src];
            if (FOLD) { bacc += bvec[ks + kk] * w; w *= g[ks + kk]; }
            const float r = __uint_as_float(f2bf(w) << 16);
            if (FOLD) csacc += r;
            scr[kk * 33 + (lane & 31)] = r;
        }
        asm volatile("s_waitcnt lgkmcnt(0)" ::: "memory");
        const int c = lane & 7;
#pragma unroll
        for (int j = 0; j < 4; ++j) {
            const int n = (lane >> 3) + 8 * j; const float* s = scr + (8 * c) * 33 + n;
            u32x4 o; o.x = cvt_pk_bf16(s[0 * 33], s[1 * 33]); o.y = cvt_pk_bf16(s[2 * 33], s[3 * 33]); o.z = cvt_pk_bf16(s[4 * 33], s[5 * 33]); o.w = cvt_pk_bf16(s[6 * 33], s[7 * 33]);
            *(u32x4*)(Bt + (size_t)(n0 + n) * K + ks + 8 * c) = o;
        }
        asm volatile("s_waitcnt lgkmcnt(0)" ::: "memory");
    }
    if (FOLD) {
        csacc += __shfl_xor(csacc, 32); bacc += __shfl_xor(bacc, 32);
        if (lane < 32) { cs[np] = csacc; bw[np] = bacc; }
    }
}

__device__ __forceinline__ void cvt_f32_bf16(const float* src, bf16_t* dst, size_t n, size_t gt, size_t GT) {
    for (size_t i = gt * 8; i < n; i += GT * 8) { const f32x4 a = *(const f32x4*)(src + i), b = *(const f32x4*)(src + i + 4); *(u32x4*)(dst + i) = pack8(a, b); }
}

struct Ptrs {
    const float *x, *p, *att_wqkv, *att_sink, *att_wo, *hg_win, *hg_lb, *hg_ng, *hg_wo, *lnm_g, *lnm_b, *ffn_win, *ffn_wout, *lnf_g, *lnf_b, *ple_wg, *ple_wp;
    float* out; unsigned char* ws;
};

typedef const Ptrs __attribute__((address_space(4)))* KP;
__device__ __forceinline__ void wconv_phase(KP Pk, int L, unsigned char* lds, int G, int blk) {
#define P (*Pk)
    int tid_l = threadIdx.x; asm volatile("" : "+v"(tid_l)); const int tid = tid_l, lane = tid & 63, wid = tid >> 6, j = L >> 1; const bool att = (L & 1) == 0;
    float* scr = (float*)(lds + wid * 16384);
    unsigned char* ws = P.ws;
    bf16_t *WIN = (bf16_t*)(ws + WS_WIN), *WOUT = (bf16_t*)(ws + WS_WOUT), *W1 = (bf16_t*)(ws + WS_W1), *W2 = (bf16_t*)(ws + WS_W2), *WG = (bf16_t*)(ws + WS_WG), *WP = (bf16_t*)(ws + WS_WP);
    float* vec = (float*)(ws + WS_VEC);
    const int nin = att ? NQKV / 32 : HIN / 32;
    const int I0 = nin, I1 = I0 + 32, I2 = I1 + 176, I3 = I2 + 128, I4 = I3 + 32, I5 = I4 + 32;
    for (int it = wid * G + blk; it < I5; it += 8 * G) {
        if (it < I0) { if (att) conv_item<1, false>(P.att_wqkv + (size_t)j * D * NQKV, D, NQKV, WIN, it * 32, 0, D, nullptr, nullptr, nullptr, nullptr, scr, lane);
                       else conv_item<0, false>(P.hg_win + (size_t)j * D * HIN, D, HIN, WIN, it * 32, 0, D, nullptr, nullptr, nullptr, nullptr, scr, lane); }
        else if (it < I1) conv_item<0, false>((att ? P.att_wo : P.hg_wo) + (size_t)j * D * D, D, D, WOUT, (it - I0) * 32, 0, D, nullptr, nullptr, nullptr, nullptr, scr, lane);
        else if (it < I2) conv_item<2, true>(P.ffn_win + (size_t)L * D * 2 * DFF, D, 2 * DFF, W1, (it - I1) * 32, 0, D, P.lnm_g + L * D, P.lnm_b + L * D, vec, vec + 5632, scr, lane);
        else if (it < I3) { const int r = it - I2; conv_item<0, false>(P.ffn_wout + (size_t)L * DFF * D, DFF, D, W2, (r >> 2) * 32, (r & 3) * 704, 704, nullptr, nullptr, nullptr, nullptr, scr, lane); }
        else if (it < I4) conv_item<0, true>(P.ple_wg + (size_t)L * D * D, D, D, WG, (it - I3) * 32, 0, D, P.lnf_g + L * D, P.lnf_b + L * D, vec + 11264, vec + 12288, scr, lane);
        else conv_item<0, false>(P.ple_wp + (size_t)L * PLE * D, PLE, D, WP, (it - I4) * 32, 0, PLE, nullptr, nullptr, nullptr, nullptr, scr, lane);
    }
    const size_t gt = (size_t)blk * 512 + tid, GT = (size_t)G * 512;
    cvt_f32_bf16(P.p + (size_t)L * M * PLE, (bf16_t*)(ws + WS_PB), (size_t)M * PLE, gt, GT);
    if (L == 0) {
        cvt_f32_bf16(P.x, (bf16_t*)(ws + WS_XBX), (size_t)M * D, gt, GT);
        float* rope = (float*)(ws + WS_ROPE);
        for (size_t i = gt; i < (size_t)SEQ * 8; i += GT) {
            const int pos = (int)(i >> 3), fi = (int)(i & 7);
            const float invs[8] = {1.0f, 0x1.8d275ep-3f, 0x1.34119p-5f, 0x1.ddee9cp-8f, 0x1.72ba44p-10f, 0x1.1f91fp-12f, 0x1.be218ap-15f, 0x1.5a0f5p-17f};
            float inv = invs[0];
#pragma unroll
            for (int q = 1; q < 8; ++q) inv = (fi == q) ? invs[q] : inv;
            const float ang = (float)pos * inv;
            const double rev = (double)ang * 0.15915494309189535; const double fr = rev - __builtin_rint(rev);
            const float x = (float)fr;
            rope[i] = __builtin_amdgcn_cosf(x); rope[(size_t)SEQ * 8 + i] = __builtin_amdgcn_sinf(x);
        }
    }
    if (!att) {
        float* lb = (float*)(ws + WS_LB);
        for (size_t i = gt; i < 2048; i += GT) {
            float v[4], mx = -1e30f;
#pragma unroll
            for (int d = 0; d < 4; ++d) { v[d] = P.hg_lb[(size_t)d * 2048 + i]; mx = fmaxf(mx, v[d]); }
            float den = 0.f, num = 0.f;
#pragma unroll
            for (int d = 0; d < 4; ++d) { const float e = __expf(v[d] - mx); den += e; if (d >= 1 && d <= L) num += e; }
            lb[i] = num / den;
        }
    }
#undef P
}

__device__ __forceinline__ int crow(int r, int hi) { return (r & 3) + 8 * (r >> 2) + 4 * hi; }
__device__ __forceinline__ void attn_phase(unsigned char* lds, const bf16_t* Q, const bf16_t* Kb, const bf16_t* Vb, bf16_t* O, const float* sink, int G, int blk) {
    int tid_l = threadIdx.x; asm volatile("" : "+v"(tid_l)); const int tid = tid_l, lane = tid & 63, wid = tid >> 6, r32 = lane & 31, hi = lane >> 5;
    bf16_t* Ks = (bf16_t*)lds; bf16_t* Vt = (bf16_t*)(lds + 384 * 72 * 2);
    for (int unit = blk; unit < 1024; unit += G) {
        const int b = unit >> 9, kvh = (unit >> 7) & 3, qb = unit & 127, start = qb * 128;
        __syncthreads();
        for (int idx = tid; idx < 384 * 8; idx += 512) {
            const int key = idx >> 3, ch = idx & 7, kpos = start - 128 + key;
            if (kpos >= 0 && kpos < SEQ) {
                const size_t gofs = ((size_t)(b * SEQ + kpos)) * 256 + kvh * 64 + ch * 8;
                const u32x4 kv = *(const u32x4*)(Kb + gofs); *(u32x4*)(Ks + key * 72 + ch * 8) = kv;
                const u32x4 vv = *(const u32x4*)(Vb + gofs);
#pragma unroll
                for (int jj = 0; jj < 4; ++jj) { const unsigned w = vv[jj]; Vt[(ch * 8 + 2 * jj) * 392 + key] = (bf16_t)(w & 0xffffu); Vt[(ch * 8 + 2 * jj + 1) * 392 + key] = (bf16_t)(w >> 16); }
            }
        }
        __syncthreads();
        const int g = wid >> 1, half = wid & 1, head = kvh * 4 + g;
        const float sk = sink[head] * LOG2E;
        for (int sb = 0; sb < 2; ++sb) {
            const int r0 = 64 * half + 32 * sb; const size_t tok = (size_t)b * SEQ + start + r0 + r32;
            bf16x8 qf[4];
#pragma unroll
            for (int ks = 0; ks < 4; ++ks) qf[ks] = *(const bf16x8*)(Q + tok * 1024 + head * 64 + 16 * ks + 8 * hi);
            float m = sk, l = 1.f; f32x16 o0 = {}, o1 = {};
            for (int j = 0; j < 9; ++j) {
                const int key0 = r0 + 32 * j, kpos0 = start - 128 + key0;
                if (kpos0 < 0 || kpos0 >= SEQ) continue;
                f32x16 s = {};
#pragma unroll
                for (int ks = 0; ks < 4; ++ks) { const bf16x8 a = *(const bf16x8*)(Ks + (key0 + r32) * 72 + 16 * ks + 8 * hi); s = __builtin_amdgcn_mfma_f32_32x32x16_bf16(a, qf[ks], s, 0, 0, 0); }
                if (j == 0) {
#pragma unroll
                    for (int r = 0; r < 16; ++r) if (crow(r, hi) < r32) s[r] = -INFINITY;
                }
                if (j == 8) {
#pragma unroll
                    for (int r = 0; r < 16; ++r) if (crow(r, hi) > r32) s[r] = -INFINITY;
                }
                float mx = s[0];
#pragma unroll
                for (int r = 1; r < 16; ++r) mx = fmaxf(mx, s[r]);
                mx = fmaxf(mx, __shfl_xor(mx, 32));
                const float mn = fmaxf(m, mx), al = __builtin_amdgcn_exp2f(m - mn);
                float rsum = 0.f;
#pragma unroll
                for (int r = 0; r < 16; ++r) { s[r] = __builtin_amdgcn_exp2f(s[r] - mn); rsum += s[r]; }
                rsum += __shfl_xor(rsum, 32);
                l = l * al + rsum; m = mn;
#pragma unroll
                for (int r = 0; r < 16; ++r) { o0[r] *= al; o1[r] *= al; }
                bf16x8 pf[2];
#pragma unroll
                for (int s2 = 0; s2 < 2; ++s2) { u32x4 w; w.x = cvt_pk_bf16(s[8 * s2 + 0], s[8 * s2 + 1]); w.y = cvt_pk_bf16(s[8 * s2 + 2], s[8 * s2 + 3]); w.z = cvt_pk_bf16(s[8 * s2 + 4], s[8 * s2 + 5]); w.w = cvt_pk_bf16(s[8 * s2 + 6], s[8 * s2 + 7]); pf[s2] = __builtin_bit_cast(bf16x8, w); }
#pragma unroll
                for (int s2 = 0; s2 < 2; ++s2) {
                    const bf16_t* v0 = Vt + r32 * 392 + key0 + 16 * s2 + 4 * hi;
                    const u32x2 a0 = *(const u32x2*)v0, a1 = *(const u32x2*)(v0 + 8);
                    const u32x2 c0 = *(const u32x2*)(v0 + 32 * 392), c1 = *(const u32x2*)(v0 + 32 * 392 + 8);
                    const u32x4 A0 = {a0.x, a0.y, a1.x, a1.y}, A1 = {c0.x, c0.y, c1.x, c1.y};
                    o0 = __builtin_amdgcn_mfma_f32_32x32x16_bf16(__builtin_bit_cast(bf16x8, A0), pf[s2], o0, 0, 0, 0);
                    o1 = __builtin_amdgcn_mfma_f32_32x32x16_bf16(__builtin_bit_cast(bf16x8, A1), pf[s2], o1, 0, 0, 0);
                }
            }
            const float inv = 1.0f / l;
            bf16_t* op = O + tok * 1024 + head * 64 + 4 * hi;
#pragma unroll
            for (int g4 = 0; g4 < 4; ++g4) {
                u32x2 w0, w1;
                w0.x = cvt_pk_bf16(o0[4 * g4] * inv, o0[4 * g4 + 1] * inv); w0.y = cvt_pk_bf16(o0[4 * g4 + 2] * inv, o0[4 * g4 + 3] * inv);
                w1.x = cvt_pk_bf16(o1[4 * g4] * inv, o1[4 * g4 + 1] * inv); w1.y = cvt_pk_bf16(o1[4 * g4 + 2] * inv, o1[4 * g4 + 3] * inv);
                *(u32x2*)(op + 8 * g4) = w0; *(u32x2*)(op + 32 + 8 * g4) = w1;
            }
        }
    }
    __syncthreads();
}

constexpr int HP = 136;
constexpr int L_TOT = 0, L_KO = 4096, L_ST = L_KO + 128 * HP * 2, L_VT = L_ST + 128 * HP * 2, L_P = L_VT + 128 * HP * 2;
static_assert(L_P + 8 * 16 * HP * 2 <= LDS_BYTES, "hgrn lds");
template <int DIR> __device__ __forceinline__ float scan16(float v) {
    if (DIR == 0) {
        v += __int_as_float(__builtin_amdgcn_update_dpp(0, __float_as_int(v), 0x111, 0xf, 0xf, true));
        v += __int_as_float(__builtin_amdgcn_update_dpp(0, __float_as_int(v), 0x112, 0xf, 0xf, true));
        v += __int_as_float(__builtin_amdgcn_update_dpp(0, __float_as_int(v), 0x114, 0xf, 0xf, true));
        v += __int_as_float(__builtin_amdgcn_update_dpp(0, __float_as_int(v), 0x118, 0xf, 0xf, true));
    } else {
        v += __int_as_float(__builtin_amdgcn_update_dpp(0, __float_as_int(v), 0x101, 0xf, 0xf, true));
        v += __int_as_float(__builtin_amdgcn_update_dpp(0, __float_as_int(v), 0x102, 0xf, 0xf, true));
        v += __int_as_float(__builtin_amdgcn_update_dpp(0, __float_as_int(v), 0x104, 0xf, 0xf, true));
        v += __int_as_float(__builtin_amdgcn_update_dpp(0, __float_as_int(v), 0x108, 0xf, 0xf, true));
    }
    return v;
}
__device__ __forceinline__ void load32(const bf16_t* p, float (&v)[32]) {
#pragma unroll
    for (int ks = 0; ks < 4; ++ks) { const u32x4 w = *(const u32x4*)(p + 32 * ks);
        v[8 * ks + 0] = bf_lo(w.x); v[8 * ks + 1] = bf_hi(w.x); v[8 * ks + 2] = bf_lo(w.y); v[8 * ks + 3] = bf_hi(w.y); v[8 * ks + 4] = bf_lo(w.z); v[8 * ks + 5] = bf_hi(w.z); v[8 * ks + 6] = bf_lo(w.w); v[8 * ks + 7] = bf_hi(w.w); }
}
__device__ __forceinline__ bf16x8 pk8(const float* v) { u32x4 w; w.x = cvt_pk_bf16(v[0], v[1]); w.y = cvt_pk_bf16(v[2], v[3]); w.z = cvt_pk_bf16(v[4], v[5]); w.w = cvt_pk_bf16(v[6], v[7]); return __builtin_bit_cast(bf16x8, w); }
#define WAVE_LDS_FENCE() do { asm volatile("s_waitcnt lgkmcnt(0)" ::: "memory"); __builtin_amdgcn_wave_barrier(); } while (0)

template <int DIR> __device__ __forceinline__ void h1_dir(unsigned char* lds, const bf16_t* zrow, int h, bf16_t* slot, float* decp) {
    int tid_l = threadIdx.x; asm volatile("" : "+v"(tid_l)); const int tid = tid_l, lane = tid & 63, wid = tid >> 6, r = lane & 15, kq = lane >> 4;
    float* TOT = (float*)(lds + L_TOT); bf16_t* KS = (bf16_t*)(lds + L_KO); bf16_t* VT = (bf16_t*)(lds + L_VT); bf16_t* STG = (bf16_t*)(lds + L_ST);
    float bl[32], kk[32];
    load32(zrow + 1024 * (1 + DIR) + h * 128 + 8 * kq, bl);
#pragma unroll
    for (int i = 0; i < 32; ++i) { kk[i] = 1.0f - __expf(bl[i]); bl[i] = scan16<DIR>(bl[i]); }
    if (r == (DIR ? 0 : 15)) {
#pragma unroll
        for (int ks = 0; ks < 4; ++ks) { *(f32x4*)(TOT + wid * 128 + 32 * ks + 8 * kq) = (f32x4){bl[8 * ks], bl[8 * ks + 1], bl[8 * ks + 2], bl[8 * ks + 3]}; *(f32x4*)(TOT + wid * 128 + 32 * ks + 8 * kq + 4) = (f32x4){bl[8 * ks + 4], bl[8 * ks + 5], bl[8 * ks + 6], bl[8 * ks + 7]}; }
    }
    __syncthreads();
    {
        float aft[32];
#pragma unroll
        for (int i = 0; i < 32; ++i) aft[i] = 0.f;
        for (int m = 0; m < 8; ++m) {
            const bool use = DIR ? (m <= wid) : (m >= wid);
            if (use) {
#pragma unroll
                for (int ks = 0; ks < 4; ++ks) { const f32x4 a = *(const f32x4*)(TOT + m * 128 + 32 * ks + 8 * kq), b = *(const f32x4*)(TOT + m * 128 + 32 * ks + 8 * kq + 4);
                    aft[8 * ks] += a[0]; aft[8 * ks + 1] += a[1]; aft[8 * ks + 2] += a[2]; aft[8 * ks + 3] += a[3]; aft[8 * ks + 4] += b[0]; aft[8 * ks + 5] += b[1]; aft[8 * ks + 6] += b[2]; aft[8 * ks + 7] += b[3]; }
            }
        }
        if (wid == (DIR ? 7 : 0) && r == 0) {
#pragma unroll
            for (int ks = 0; ks < 4; ++ks)
#pragma unroll
                for (int e = 0; e < 8; ++e) decp[32 * ks + 8 * kq + e] = __expf(aft[8 * ks + e]);
        }
#pragma unroll
        for (int ks = 0; ks < 4; ++ks)
#pragma unroll
            for (int e = 0; e < 8; ++e) KS[(32 * ks + 8 * kq + e) * HP + 16 * wid + r] = (bf16_t)f2bf(kk[8 * ks + e] * __expf(aft[8 * ks + e] - bl[8 * ks + e]));
    }
    __syncthreads();
    f32x4 acc[8];
#pragma unroll
    for (int nt = 0; nt < 8; ++nt) acc[nt] = (f32x4){0.f, 0.f, 0.f, 0.f};
#pragma unroll
    for (int ks = 0; ks < 4; ++ks) {
        const bf16x8 a = *(const bf16x8*)(VT + (16 * wid + r) * HP + 32 * ks + 8 * kq);
#pragma unroll
        for (int nt = 0; nt < 8; ++nt) { const bf16x8 bb = *(const bf16x8*)(KS + (16 * nt + r) * HP + 32 * ks + 8 * kq); acc[nt] = __builtin_amdgcn_mfma_f32_16x16x32_bf16(a, bb, acc[nt], 0, 0, 0); }
    }
#pragma unroll
    for (int nt = 0; nt < 8; ++nt)
#pragma unroll
        for (int i = 0; i < 4; ++i) STG[(16 * wid + 4 * kq + i) * HP + 16 * nt + r] = (bf16_t)f2bf(acc[nt][i]);
    WAVE_LDS_FENCE();
#pragma unroll
    for (int it = 0; it < 4; ++it) { const int p = lane + 64 * it, row = p >> 4, c16 = p & 15; *(u32x4*)(slot + (size_t)(16 * wid + row) * 128 + c16 * 8) = *(const u32x4*)(STG + (16 * wid + row) * HP + c16 * 8); }
    __syncthreads();
}
__device__ __forceinline__ void h1_phase(unsigned char* lds, unsigned char* ws, int G, int blk) {
    int tid_l = threadIdx.x; asm volatile("" : "+v"(tid_l)); const int tid = tid_l, lane = tid & 63, wid = tid >> 6, r = lane & 15, kq = lane >> 4;
    const bf16_t* Z = (const bf16_t*)(ws + WS_Z); bf16_t* VT = (bf16_t*)(lds + L_VT);
    for (int unit = blk; unit < 2048; unit += G) {
        const int b = unit >> 10, c = (unit >> 3) & 127, h = unit & 7, chain = b * 8 + h;
        const bf16_t* zrow = Z + ((size_t)b * SEQ + c * 128 + 16 * wid + r) * HIN;
        { float vv[32]; load32(zrow + 3072 + h * 128 + 8 * kq, vv);
#pragma unroll
          for (int ks = 0; ks < 4; ++ks)
#pragma unroll
              for (int e = 0; e < 8; ++e) VT[(32 * ks + 8 * kq + e) * HP + 16 * wid + r] = (bf16_t)(__float_as_uint(vv[8 * ks + e]) >> 16); }
        h1_dir<0>(lds, zrow, h, (bf16_t*)(ws + WS_SF) + ((size_t)chain * 128 + c) * 16384, (float*)(ws + WS_DEC) + ((size_t)(0 * 16 + chain) * 128 + c) * 128);
        h1_dir<1>(lds, zrow, h, (bf16_t*)(ws + WS_SB) + ((size_t)chain * 128 + c) * 16384, (float*)(ws + WS_DEC) + ((size_t)(1 * 16 + chain) * 128 + c) * 128);
    }
}
__device__ __forceinline__ void h2_phase(unsigned char* ws, int G, int blk) {
    int tid_l = threadIdx.x; asm volatile("" : "+v"(tid_l));
    const size_t gt = (size_t)blk * 512 + tid_l, GT = (size_t)G * 512;
    for (size_t w = gt; w < (size_t)32 * 4096; w += GT) {
        const int ch32 = (int)(w >> 12), dir = ch32 >> 4, chain = ch32 & 15, e4 = (int)(w & 4095);
        bf16_t* base = (bf16_t*)(ws + (dir ? WS_SB : WS_SF)) + (size_t)chain * 128 * 16384 + (size_t)e4 * 4;
        const float* dbase = (const float*)(ws + WS_DEC) + ((size_t)(dir * 16 + chain) * 128) * 128 + ((e4 * 4) & 127);
        f32x4 S = {0.f, 0.f, 0.f, 0.f};
        for (int s0 = 0; s0 < 128; s0 += 8) {
            u32x2 raw[8]; f32x4 dd[8];
#pragma unroll
            for (int k = 0; k < 8; ++k) { const int c = dir ? 127 - (s0 + k) : (s0 + k); raw[k] = *(const u32x2*)(base + (size_t)c * 16384); dd[k] = *(const f32x4*)(dbase + (size_t)c * 128); }
#pragma unroll
            for (int k = 0; k < 8; ++k) { const int c = dir ? 127 - (s0 + k) : (s0 + k);
                u32x2 o; o.x = cvt_pk_bf16(S[0], S[1]); o.y = cvt_pk_bf16(S[2], S[3]); *(u32x2*)(base + (size_t)c * 16384) = o;
                const f32x4 ds = {bf_lo(raw[k].x), bf_hi(raw[k].x), bf_lo(raw[k].y), bf_hi(raw[k].y)}; S = dd[k] * S + ds; }
        }
    }
}
template <int DIR> __device__ __forceinline__ void h3_dir(unsigned char* lds, const bf16_t* zrow, int h, const bf16_t* slot, f32x4 (&o)[8]) {
    int tid_l = threadIdx.x; asm volatile("" : "+v"(tid_l)); const int tid = tid_l, lane = tid & 63, wid = tid >> 6, r = lane & 15, kq = lane >> 4;
    float* TOT = (float*)(lds + L_TOT); bf16_t* KO = (bf16_t*)(lds + L_KO); bf16_t* ST = (bf16_t*)(lds + L_ST); const bf16_t* VT = (const bf16_t*)(lds + L_VT); bf16_t* Pw = (bf16_t*)(lds + L_P) + wid * 16 * HP;
    float bl[32], qin[32]; bf16x8 kin[4];
    load32(zrow + 1024 * (1 + DIR) + h * 128 + 8 * kq, bl);
    load32(zrow + h * 128 + 8 * kq, qin);
    {
        float kk[32];
#pragma unroll
        for (int i = 0; i < 32; ++i) { kk[i] = 1.0f - __expf(bl[i]); bl[i] = scan16<DIR>(bl[i]); }
        if (r == (DIR ? 0 : 15)) {
#pragma unroll
            for (int ks = 0; ks < 4; ++ks) { *(f32x4*)(TOT + wid * 128 + 32 * ks + 8 * kq) = (f32x4){bl[8 * ks], bl[8 * ks + 1], bl[8 * ks + 2], bl[8 * ks + 3]}; *(f32x4*)(TOT + wid * 128 + 32 * ks + 8 * kq + 4) = (f32x4){bl[8 * ks + 4], bl[8 * ks + 5], bl[8 * ks + 6], bl[8 * ks + 7]}; }
        }
#pragma unroll
        for (int it = 0; it < 4; ++it) { const int p = tid + 512 * it, v = p >> 4, c16 = p & 15; *(u32x4*)(ST + v * HP + c16 * 8) = *(const u32x4*)(slot + (size_t)v * 128 + c16 * 8); }
#pragma unroll
        for (int it = 0; it < 4; ++it) { const int p = lane + 64 * it; *(u32x4*)(Pw + (p >> 4) * HP + (p & 15) * 8) = (u32x4){0u, 0u, 0u, 0u}; }
        __syncthreads();
        float tmp[8];
#pragma unroll
        for (int ks = 0; ks < 4; ++ks) {
            const f32x4 a = *(const f32x4*)(TOT + wid * 128 + 32 * ks + 8 * kq), b = *(const f32x4*)(TOT + wid * 128 + 32 * ks + 8 * kq + 4);
            const float tw[8] = {a[0], a[1], a[2], a[3], b[0], b[1], b[2], b[3]};
#pragma unroll
            for (int e = 0; e < 8; ++e) tmp[e] = kk[8 * ks + e] * __expf(tw[e] - bl[8 * ks + e]);
            *(bf16x8*)(KO + (16 * wid + r) * HP + 32 * ks + 8 * kq) = pk8(tmp);
#pragma unroll
            for (int e = 0; e < 8; ++e) tmp[e] = kk[8 * ks + e] * __expf(fminf(-bl[8 * ks + e], 80.f));
            kin[ks] = pk8(tmp);
        }
#pragma unroll
        for (int i = 0; i < 32; ++i) qin[i] *= __expf(bl[i]);
    }
    __syncthreads();
    {
        f32x4 sc = {0.f, 0.f, 0.f, 0.f};
#pragma unroll
        for (int ks = 0; ks < 4; ++ks) sc = __builtin_amdgcn_mfma_f32_16x16x32_bf16(pk8(qin + 8 * ks), kin[ks], sc, 0, 0, 0);
#pragma unroll
        for (int i = 0; i < 4; ++i) { const int t = 4 * kq + i; const bool keep = DIR ? (r >= t) : (r <= t); Pw[t * HP + 16 * wid + r] = (bf16_t)f2bf(keep ? sc[i] : 0.f); }
    }
    float run[32];
#pragma unroll
    for (int i = 0; i < 32; ++i) run[i] = 0.f;
    for (int d = 1; d < 8; ++d) {
        const int m = DIR ? wid + d : wid - d;
        if (m < 0 || m > 7) break;
        f32x4 sc = {0.f, 0.f, 0.f, 0.f};
#pragma unroll
        for (int ks = 0; ks < 4; ++ks) {
            float tmp[8];
#pragma unroll
            for (int e = 0; e < 8; ++e) tmp[e] = qin[8 * ks + e] * __expf(run[8 * ks + e]);
            const bf16x8 bb = *(const bf16x8*)(KO + (16 * m + r) * HP + 32 * ks + 8 * kq);
            sc = __builtin_amdgcn_mfma_f32_16x16x32_bf16(pk8(tmp), bb, sc, 0, 0, 0);
            const f32x4 a = *(const f32x4*)(TOT + m * 128 + 32 * ks + 8 * kq), b = *(const f32x4*)(TOT + m * 128 + 32 * ks + 8 * kq + 4);
            run[8 * ks] += a[0]; run[8 * ks + 1] += a[1]; run[8 * ks + 2] += a[2]; run[8 * ks + 3] += a[3]; run[8 * ks + 4] += b[0]; run[8 * ks + 5] += b[1]; run[8 * ks + 6] += b[2]; run[8 * ks + 7] += b[3];
        }
#pragma unroll
        for (int i = 0; i < 4; ++i) Pw[(4 * kq + i) * HP + 16 * m + r] = (bf16_t)f2bf(sc[i]);
    }
#pragma unroll
    for (int i = 0; i < 32; ++i) qin[i] *= __expf(run[i]);
    WAVE_LDS_FENCE();
#pragma unroll
    for (int ks = 0; ks < 4; ++ks) {
        const bf16x8 aq = pk8(qin + 8 * ks), ap = *(const bf16x8*)(Pw + r * HP + 32 * ks + 8 * kq);
#pragma unroll
        for (int nt = 0; nt < 8; ++nt) {
            o[nt] = __builtin_amdgcn_mfma_f32_16x16x32_bf16(aq, *(const bf16x8*)(ST + (16 * nt + r) * HP + 32 * ks + 8 * kq), o[nt], 0, 0, 0);
            o[nt] = __builtin_amdgcn_mfma_f32_16x16x32_bf16(ap, *(const bf16x8*)(VT + (16 * nt + r) * HP + 32 * ks + 8 * kq), o[nt], 0, 0, 0);
        }
    }
    __syncthreads();
}
__device__ __forceinline__ void h3_phase(unsigned char* lds, unsigned char* ws, const float* norm_g, int G, int blk) {
    int tid_l = threadIdx.x; asm volatile("" : "+v"(tid_l)); const int tid = tid_l, lane = tid & 63, wid = tid >> 6, r = lane & 15, kq = lane >> 4;
    bf16_t* Z = (bf16_t*)(ws + WS_Z); bf16_t* VT = (bf16_t*)(lds + L_VT); float* STGF = (float*)(lds + L_KO) + wid * 16 * 132;
    for (int unit = blk; unit < 2048; unit += G) {
        const int b = unit >> 10, c = (unit >> 3) & 127, h = unit & 7, chain = b * 8 + h;
        const size_t tok0 = (size_t)b * SEQ + c * 128 + 16 * wid;
        const bf16_t* zrow = Z + (tok0 + r) * HIN;
        { float vv[32]; load32(zrow + 3072 + h * 128 + 8 * kq, vv);
#pragma unroll
          for (int ks = 0; ks < 4; ++ks)
#pragma unroll
              for (int e = 0; e < 8; ++e) VT[(32 * ks + 8 * kq + e) * HP + 16 * wid + r] = (bf16_t)(__float_as_uint(vv[8 * ks + e]) >> 16); }
        f32x4 o[8];
#pragma unroll
        for (int nt = 0; nt < 8; ++nt) o[nt] = (f32x4){0.f, 0.f, 0.f, 0.f};
        h3_dir<0>(lds, zrow, h, (const bf16_t*)(ws + WS_SF) + ((size_t)chain * 128 + c) * 16384, o);
        h3_dir<1>(lds, zrow, h, (const bf16_t*)(ws + WS_SB) + ((size_t)chain * 128 + c) * 16384, o);
        float ssq[4];
#pragma unroll
        for (int i = 0; i < 4; ++i) { float s = 0.f;
#pragma unroll
            for (int nt = 0; nt < 8; ++nt) s += o[nt][i] * o[nt][i];
            s += __shfl_xor(s, 1); s += __shfl_xor(s, 2); s += __shfl_xor(s, 4); s += __shfl_xor(s, 8);
            ssq[i] = 1.0f / sqrtf(s * (1.0f / 128.0f) + LN_EPS); }
#pragma unroll
        for (int nt = 0; nt < 8; ++nt)
#pragma unroll
            for (int i = 0; i < 4; ++i) STGF[(4 * kq + i) * 132 + 16 * nt + r] = o[nt][i] * ssq[i];
        WAVE_LDS_FENCE();
#pragma unroll
        for (int it = 0; it < 4; ++it) {
            const int p = lane + 64 * it, row = p >> 4, c8 = p & 15;
            const f32x4 a = *(const f32x4*)(STGF + row * 132 + c8 * 8), bq = *(const f32x4*)(STGF + row * 132 + c8 * 8 + 4);
            const f32x4 g0 = *(const f32x4*)(norm_g + c8 * 8), g1 = *(const f32x4*)(norm_g + c8 * 8 + 4);
            bf16_t* zr = Z + (tok0 + row) * HIN + h * 128 + c8 * 8;
            const u32x4 gw = *(const u32x4*)(zr + 4096);
            const f32x4 t0 = {bf_lo(gw.x), bf_hi(gw.x), bf_lo(gw.y), bf_hi(gw.y)}, t1 = {bf_lo(gw.z), bf_hi(gw.z), bf_lo(gw.w), bf_hi(gw.w)};
            *(u32x4*)zr = pack8(a * g0 * t0, bq * g1 * t1);
        }
        __syncthreads();
    }
}

#define GEMM_PHASE(EPI, Aptr, LDA, Bptr, LDB, NN, KK, Eobj) do { pg8::Gemm g_{(const bf16_t*)(Aptr), (const bf16_t*)(Bptr), M, (NN), (KK), (LDA), (LDB)}; pg8::StaticOrder S_; S_.init(M, (NN), G, blk); \
    pg8::gemm_phase<EPI, pg8::StaticOrder, true, true>((PG8_LAS unsigned char*)lds, g_, S_, (Eobj)); } while (0)

#define KPTR() KP kp = (KP)__builtin_amdgcn_kernarg_segment_ptr(); int G = gridDim.x, blk = blockIdx.x; asm volatile("" : "+s"(kp), "+s"(G), "+s"(blk)); unsigned char* ws = kp->ws; (void)ws
template <int L> __device__ __forceinline__ void layer_fwd(unsigned char* lds, cg::grid_group& grid) {
        constexpr int j = L >> 1; constexpr bool att = (L & 1) == 0;
        { KPTR(); wconv_phase(kp, L, lds, G, blk); }
        grid.sync();
        if (att) {
            { KPTR(); EpiQKV E{(bf16_t*)(ws + WS_Q), (bf16_t*)(ws + WS_K), (bf16_t*)(ws + WS_V), (const float*)(ws + WS_ROPE)}; GEMM_PHASE(EpiQKV, ws + WS_XBX, D, ws + WS_WIN, D, NQKV, D, E); }
            grid.sync();
            { KPTR(); attn_phase(lds, (const bf16_t*)(ws + WS_Q), (const bf16_t*)(ws + WS_K), (const bf16_t*)(ws + WS_V), (bf16_t*)(ws + WS_O), kp->att_sink + j * 16, G, blk); }
            grid.sync();
            { KPTR(); EpiRes<false> E{L == 0 ? kp->x : kp->out, kp->out, (bf16_t*)(ws + WS_XBX), (f32x2*)(ws + WS_ST1), nullptr, nullptr, nullptr}; GEMM_PHASE(EpiRes<false>, ws + WS_O, D, ws + WS_WOUT, D, D, D, E); }
            grid.sync();
        } else {
            { KPTR(); EpiHin E{(bf16_t*)(ws + WS_Z), (const float*)(ws + WS_LB)}; GEMM_PHASE(EpiHin, ws + WS_XBX, D, ws + WS_WIN, D, HIN, D, E); }
            grid.sync();
            { KPTR(); h1_phase(lds, ws, G, blk); }
            grid.sync();
            { KPTR(); h2_phase(ws, G, blk); }
            grid.sync();
            { KPTR(); h3_phase(lds, ws, kp->hg_ng + j * 128, G, blk); }
            grid.sync();
            { KPTR(); EpiRes<false> E{kp->out, kp->out, (bf16_t*)(ws + WS_XBX), (f32x2*)(ws + WS_ST1), nullptr, nullptr, nullptr}; GEMM_PHASE(EpiRes<false>, ws + WS_Z, HIN, ws + WS_WOUT, D, D, D, E); }
            grid.sync();
        }
        { KPTR(); float* vec = (float*)(ws + WS_VEC); EpiFfn1 E{(bf16_t*)(ws + WS_H), (const f32x2*)(ws + WS_ST1), vec, vec + 5632}; GEMM_PHASE(EpiFfn1, ws + WS_XBX, D, ws + WS_W1, D, 2 * DFF, D, E); }
        { KPTR(); EpiPlain E{(bf16_t*)(ws + WS_PP), D}; GEMM_PHASE(EpiPlain, ws + WS_PB, PLE, ws + WS_WP, PLE, D, PLE, E); }
        grid.sync();
        { KPTR(); EpiRes<true> E{kp->out, kp->out, (bf16_t*)(ws + WS_XBY), (f32x2*)(ws + WS_ST2), (const f32x2*)(ws + WS_ST1), kp->lnm_g + L * D, kp->lnm_b + L * D}; GEMM_PHASE(EpiRes<true>, ws + WS_H, DFF, ws + WS_W2, DFF, D, DFF, E); }
        grid.sync();
        { KPTR(); float* vec = (float*)(ws + WS_VEC); EpiPle E{kp->out, (bf16_t*)(ws + WS_XBX), (const f32x2*)(ws + WS_ST2), kp->lnf_g + L * D, kp->lnf_b + L * D, vec + 11264, vec + 12288, (const bf16_t*)(ws + WS_PP)}; GEMM_PHASE(EpiPle, ws + WS_XBY, D, ws + WS_WG, D, D, D, E); }
        grid.sync();
}
__global__ void __launch_bounds__(512, 2) mk_fwd(Ptrs Parg) {
    extern __shared__ __attribute__((aligned(16))) unsigned char lds[];
    cg::grid_group grid = cg::this_grid();
    layer_fwd<0>(lds, grid); layer_fwd<1>(lds, grid); layer_fwd<2>(lds, grid); layer_fwd<3>(lds, grid);
}

extern "C" void kernel_launch(void* const* d_in, const int* in_sizes, int n_in, void* d_out, int out_size, void* d_ws, size_t ws_size, hipStream_t stream) {
    static int grid = 0;
    if (grid == 0) {
        if (n_in != 17 || out_size != M * D || ws_size < WS_END) { fprintf(stderr, "kernel_launch: unexpected problem: n_in %d out %d ws %zu (need %zu)\n", n_in, out_size, ws_size, (size_t)WS_END); grid = -1; return; }
        int dev = 0, cus = 0, per_cu = 0;
        (void)hipGetDevice(&dev);
        (void)hipDeviceGetAttribute(&cus, hipDeviceAttributeMultiprocessorCount, dev);
        (void)hipFuncSetAttribute((const void*)mk_fwd, hipFuncAttributeMaxDynamicSharedMemorySize, LDS_BYTES);
        (void)hipOccupancyMaxActiveBlocksPerMultiprocessor(&per_cu, (const void*)mk_fwd, 512, LDS_BYTES);
        if (per_cu < 1) fprintf(stderr, "kernel_launch: occupancy query says %d blocks/CU\n", per_cu);
        (void)hipGetLastError();
        grid = cus;
    }
    if (grid < 0) return;
    Ptrs p{};
    p.x = (const float*)d_in[0]; p.p = (const float*)d_in[1]; p.att_wqkv = (const float*)d_in[2]; p.att_sink = (const float*)d_in[3]; p.att_wo = (const float*)d_in[4];
    p.hg_win = (const float*)d_in[5]; p.hg_lb = (const float*)d_in[6]; p.hg_ng = (const float*)d_in[7]; p.hg_wo = (const float*)d_in[8];
    p.lnm_g = (const float*)d_in[9]; p.lnm_b = (const float*)d_in[10]; p.ffn_win = (const float*)d_in[11]; p.ffn_wout = (const float*)d_in[12];
    p.lnf_g = (const float*)d_in[13]; p.lnf_b = (const float*)d_in[14]; p.ple_wg = (const float*)d_in[15]; p.ple_wp = (const float*)d_in[16];
    p.out = (float*)d_out; p.ws = (unsigned char*)d_ws;
    void* args[] = {&p};
    hipError_t e = hipLaunchCooperativeKernel((const void*)mk_fwd, dim3(grid), dim3(512), args, LDS_BYTES, stream);
    if (e != hipSuccess) fprintf(stderr, "kernel_launch: cooperative launch failed: %s (grid %d)\n", hipGetErrorString(e), grid);
}
```

```cpp
#include <hip/hip_runtime.h>
#include <hip/hip_cooperative_groups.h>
#include <cstdio>
#include <cstdint>
namespace cg = cooperative_groups;
namespace pg8 {
#define PG8_LAS __attribute__((address_space(3)))
typedef unsigned short bf16_t;
typedef short bf16x8 __attribute__((ext_vector_type(8)));
typedef float f32x4 __attribute__((ext_vector_type(4)));
typedef unsigned u32x4 __attribute__((ext_vector_type(4)));
constexpr int BM = 256, BK = 64, HALF = 128, HTB = HALF * BK * 2  , STAGE_BYTES = 8 * HTB, NXCD = 8, WGM = 8;

__host__ __device__ __forceinline__ int lds_byte(int r, int c) { const int st = (r >> 4) * 2 + (c >> 5), rr = r & 15, cc = c & 31, ob = rr * 64 + cc * 2; return st * 1024 + (ob ^ (((ob >> 9) & 1) << 5)); }
__host__ __device__ __forceinline__ void stage_rc(int b, int& R, int& C) { const int st = b / 1024, sb = b % 1024, swz = sb ^ (((sb >> 9) & 1) << 5); R = (st >> 1) * 16 + swz / 64; C = (st & 1) * 32 + (swz % 64) / 2; }
__host__ __device__ __forceinline__ int perm32(int rho) { const int n = rho >> 4, i = rho & 15; return 8 * (i >> 2) + 4 * n + (i & 3); }

struct Unit { int pm, pn; };
struct Gemm { const bf16_t* A; const bf16_t* Bt; int M, N, K, lda, ldb; };

struct StaticOrder {
    int nM, nN, nwg, G, c;
    __host__ __device__ void init(int M, int N, int G_, int c_) { nM = M / BM; nN = N / BM; nwg = nM * nN; G = G_; c = c_; }
    __host__ __device__ bool next(int i, Unit& u) const {
        const long L = (long)i * G + c; if (L >= nwg) return false;
        int wgid = (int)L; { const int q = nwg / NXCD, r = nwg % NXCD, xcd = wgid % NXCD, off = wgid / NXCD; wgid = (xcd < r ? xcd * (q + 1) : r * (q + 1) + (xcd - r) * q) + off; }
        const int nig = WGM * nN, gid = wgid / nig, fm = gid * WGM, gsz = (nM - fm) < WGM ? (nM - fm) : WGM;
        u.pm = fm + ((wgid % nig) % gsz); u.pn = (wgid % nig) / gsz; return true;
    }
    __device__ __forceinline__ void a_ready(const Unit&) const {}
    __device__ __forceinline__ void done(const Unit&) const {}
};

__device__ __forceinline__ unsigned cvt_pk_bf16(float lo, float hi) { unsigned r; asm volatile("v_cvt_pk_bf16_f32 %0, %1, %2" : "=v"(r) : "v"(lo), "v"(hi)); return r; }
template <class Epi, class Sched, bool ALIGN_EPI = false, bool SP2 = false>
__device__ __forceinline__ void gemm_phase(PG8_LAS unsigned char* lds, const Gemm g, const Sched& S, const Epi& E) {
    int tid_l = threadIdx.x; asm volatile("" : "+v"(tid_l));
    const int tid = tid_l, wid = __builtin_amdgcn_readfirstlane(tid >> 6), lane = tid & 63, wr = wid >> 2, wc = wid & 3, fr = lane & 15, fq = lane >> 4;
    const int K = g.K, nt = K / BK;
    unsigned voffA[2], voffB[2];
#pragma unroll
    for (int i = 0; i < 2; ++i) { int R, C; stage_rc(tid * 16 + i * 8192, R, C); const int Rb = Epi::PERM ? ((R & ~31) + perm32(R & 31)) : R;
        voffA[i] = (unsigned)(R * g.lda + C) * 2u; voffB[i] = (unsigned)(Rb * g.ldb + C) * 2u; }
    const size_t kstep = (size_t)(BK * 2);
    const size_t hstepA = (size_t)HALF * g.lda * 2, hstepB = (size_t)HALF * g.ldb * 2;
    const size_t tstepA = 2 * hstepA, tstepB = 2 * hstepB;
    const unsigned ldsw = (unsigned)wid * 1024u;
    const int aoff = lds_byte(wr * 64 + fr, fq * 8), boff = lds_byte(wc * 32 + fr, fq * 8);
#define PG8_SA(b, h) (((b) * 2 + (h)) * HTB)
#define PG8_SB(b, h) ((4 + (b) * 2 + (h)) * HTB)
#define PG8_STAGE(bufoff, gbase, voff) do { _Pragma("unroll") for (int _i = 0; _i < 2; ++_i) \
        __builtin_amdgcn_global_load_lds((const unsigned*)((const char*)(gbase) + (voff)[_i]), (PG8_LAS unsigned*)(lds + (bufoff) + ldsw + _i * 8192), 16, 0, 0); } while (0)
#define PG8_LDA(dst, b, h) do { _Pragma("unroll") for (int m = 0; m < 4; ++m) _Pragma("unroll") for (int k = 0; k < 2; ++k) dst[m][k] = *(const PG8_LAS bf16x8*)(lds + PG8_SA(b, h) + aoff + m * 2048 + k * 1024); } while (0)
#define PG8_LDB(dst, b, h) do { _Pragma("unroll") for (int n = 0; n < 2; ++n) _Pragma("unroll") for (int k = 0; k < 2; ++k) dst[n][k] = *(const PG8_LAS bf16x8*)(lds + PG8_SB(b, h) + boff + n * 2048 + k * 1024); } while (0)
#define PG8_MMA(ai, bj, At, Bt) do { __builtin_amdgcn_s_setprio(1); _Pragma("unroll") for (int m = 0; m < 4; ++m) _Pragma("unroll") for (int n = 0; n < 2; ++n) _Pragma("unroll") for (int k = 0; k < 2; ++k) \
        acc[ai][bj][m][n] = __builtin_amdgcn_mfma_f32_16x16x32_bf16(Bt[n][k], At[m][k], acc[ai][bj][m][n], 0, 0, 0); __builtin_amdgcn_s_setprio(0); } while (0)
#define PG8_WAIT_V(n) asm volatile("s_waitcnt vmcnt(" #n ")" ::: "memory")
#define PG8_WAIT_L(n) asm volatile("s_waitcnt lgkmcnt(" #n ")" ::: "memory")
#define PG8_BAR __builtin_amdgcn_s_barrier()
#define PG8_SCHED __builtin_amdgcn_sched_barrier(0)
    Unit cur, nxt; int ui = 0;
    if (!S.next(0, cur)) return;
    f32x4 acc[2][2][4][2];
#pragma unroll
    for (int a = 0; a < 2; ++a)
#pragma unroll
        for (int b = 0; b < 2; ++b)
#pragma unroll
            for (int m = 0; m < 4; ++m)
#pragma unroll
                for (int n = 0; n < 2; ++n) acc[a][b][m][n] = (f32x4){0.f, 0.f, 0.f, 0.f};
    bf16x8 At[4][2], B0[2][2], B1[2][2];
    const char* cA = (const char*)g.A + (size_t)cur.pm * tstepA; const char* cB = (const char*)g.Bt + (size_t)cur.pn * tstepB;
    S.a_ready(cur);
    if constexpr (SP2) {
        PG8_STAGE(PG8_SB(0, 0), cB, voffB); PG8_STAGE(PG8_SB(0, 1), cB + hstepB, voffB); PG8_STAGE(PG8_SA(0, 0), cA, voffA); PG8_STAGE(PG8_SA(0, 1), cA + hstepA, voffA);
        if (wr == 1) PG8_BAR;
        PG8_WAIT_V(2); PG8_BAR;
        PG8_STAGE(PG8_SB(1, 0), cB + kstep, voffB); PG8_STAGE(PG8_SA(1, 0), cA + kstep, voffA); PG8_STAGE(PG8_SB(1, 1), cB + hstepB + kstep, voffB);
        PG8_WAIT_V(6); PG8_BAR;
    } else {
        PG8_STAGE(PG8_SB(0, 0), cB, voffB); PG8_STAGE(PG8_SA(0, 0), cA, voffA); PG8_STAGE(PG8_SB(0, 1), cB + hstepB, voffB); PG8_STAGE(PG8_SA(0, 1), cA + hstepA, voffA);
        if (wr == 1) PG8_BAR;
        PG8_WAIT_V(4); PG8_BAR;
        PG8_STAGE(PG8_SB(1, 0), cB + kstep, voffB); PG8_STAGE(PG8_SA(1, 0), cA + kstep, voffA); PG8_STAGE(PG8_SB(1, 1), cB + hstepB + kstep, voffB);
        PG8_WAIT_V(6); PG8_BAR;
    }
    for (;;) {
        const bool has_next = S.next(ui + 1, nxt);
        const char* nA = has_next ? (const char*)g.A + (size_t)nxt.pm * tstepA : cA; const char* nB = has_next ? (const char*)g.Bt + (size_t)nxt.pn * tstepB : cB;
        for (int t = 0; t < nt; t += 2) {
            const bool last = (t == nt - 2);
            const char* a1 = cA + (size_t)(t + 1) * kstep;
            const char* a2 = last ? nA : cA + (size_t)(t + 2) * kstep; const char* b2 = last ? nB : cB + (size_t)(t + 2) * kstep;
            const char* a3 = a2 + kstep; const char* b3 = b2 + kstep;
            if (last && has_next) S.a_ready(nxt);
            if constexpr (SP2) {
            PG8_LDB(B0, 0, 0); PG8_LDB(B1, 0, 1); PG8_SCHED; PG8_LDA(At, 0, 0); PG8_STAGE(PG8_SA(1, 1), a1 + hstepA, voffA);
            PG8_WAIT_V(8); PG8_WAIT_L(0); PG8_BAR; PG8_MMA(0, 0, At, B0); PG8_MMA(0, 1, At, B1); PG8_BAR; PG8_SCHED;
            PG8_LDA(At, 0, 1); PG8_STAGE(PG8_SB(0, 0), b2, voffB); PG8_STAGE(PG8_SB(0, 1), b2 + hstepB, voffB); PG8_STAGE(PG8_SA(0, 0), a2, voffA);
            PG8_WAIT_V(8); PG8_WAIT_L(0); PG8_BAR; PG8_MMA(1, 0, At, B0); PG8_MMA(1, 1, At, B1); PG8_BAR; PG8_SCHED;
            PG8_LDB(B0, 1, 0); PG8_LDB(B1, 1, 1); PG8_SCHED; PG8_LDA(At, 1, 0); PG8_STAGE(PG8_SA(0, 1), a2 + hstepA, voffA);
            PG8_WAIT_V(8); PG8_WAIT_L(0); PG8_BAR; PG8_MMA(0, 0, At, B0); PG8_MMA(0, 1, At, B1); PG8_BAR; PG8_SCHED;
            PG8_LDA(At, 1, 1); PG8_STAGE(PG8_SB(1, 0), b3, voffB); PG8_STAGE(PG8_SB(1, 1), b3 + hstepB, voffB); PG8_STAGE(PG8_SA(1, 0), a3, voffA);
            PG8_WAIT_V(8); PG8_WAIT_L(0); PG8_BAR; PG8_MMA(1, 0, At, B0); PG8_MMA(1, 1, At, B1); PG8_BAR; PG8_SCHED;
            } else {
            PG8_LDB(B0, 0, 0); PG8_SCHED; PG8_LDA(At, 0, 0); PG8_STAGE(PG8_SA(1, 1), a1 + hstepA, voffA);
            PG8_WAIT_L(8); PG8_BAR; PG8_WAIT_L(0); PG8_MMA(0, 0, At, B0); PG8_BAR; PG8_SCHED;
            PG8_LDB(B1, 0, 1); PG8_STAGE(PG8_SB(0, 0), b2, voffB);
            PG8_BAR; PG8_WAIT_L(0); PG8_MMA(0, 1, At, B1); PG8_BAR;
            PG8_LDA(At, 0, 1); PG8_STAGE(PG8_SA(0, 0), a2, voffA);
            PG8_BAR; PG8_WAIT_L(0); PG8_MMA(1, 0, At, B0); PG8_BAR; PG8_SCHED;
            PG8_STAGE(PG8_SB(0, 1), b2 + hstepB, voffB);
            PG8_WAIT_V(6); PG8_BAR; PG8_MMA(1, 1, At, B1); PG8_BAR;
            PG8_LDB(B0, 1, 0); PG8_SCHED; PG8_LDA(At, 1, 0); PG8_STAGE(PG8_SA(0, 1), a2 + hstepA, voffA);
            PG8_WAIT_L(8); PG8_BAR; PG8_WAIT_L(0); PG8_MMA(0, 0, At, B0); PG8_BAR; PG8_SCHED;
            PG8_LDB(B1, 1, 1); PG8_STAGE(PG8_SB(1, 0), b3, voffB);
            PG8_BAR; PG8_WAIT_L(0); PG8_MMA(0, 1, At, B1); PG8_BAR;
            PG8_LDA(At, 1, 1); PG8_STAGE(PG8_SA(1, 0), a3, voffA);
            PG8_BAR; PG8_WAIT_L(0); PG8_MMA(1, 0, At, B0); PG8_BAR; PG8_SCHED;
            PG8_STAGE(PG8_SB(1, 1), b3 + hstepB, voffB);
            PG8_WAIT_V(6); PG8_BAR; PG8_MMA(1, 1, At, B1); PG8_BAR;
            }
        }
        if constexpr (ALIGN_EPI) { if (wr == 0) PG8_BAR; }
        if constexpr (!Epi::AFTER_DRAIN) { E(acc, cur, wr, wc, fr, fq); S.done(cur); }
        if (!has_next) break;
#pragma unroll
        for (int a = 0; a < 2; ++a)
#pragma unroll
            for (int b = 0; b < 2; ++b)
#pragma unroll
                for (int m = 0; m < 4; ++m)
#pragma unroll
                    for (int n = 0; n < 2; ++n) acc[a][b][m][n] = (f32x4){0.f, 0.f, 0.f, 0.f};
        cur = nxt; cA = nA; cB = nB; ++ui;
        if constexpr (ALIGN_EPI) { if (wr == 1) PG8_BAR; }
    }
    PG8_WAIT_V(0);
    if constexpr (!ALIGN_EPI) { if (wr == 0) PG8_BAR; }
    PG8_BAR;
    if constexpr (Epi::AFTER_DRAIN) { E.fused(acc, cur, wr, wc, fr, fq, lds, wid, lane); S.done(cur); }
#undef PG8_SA
#undef PG8_SB
#undef PG8_STAGE
#undef PG8_LDA
#undef PG8_LDB
#undef PG8_MMA
#undef PG8_WAIT_V
#undef PG8_WAIT_L
#undef PG8_BAR
#undef PG8_SCHED
}
}

using pg8::bf16_t; using pg8::bf16x8; using pg8::f32x4; using pg8::u32x4; using pg8::Unit; using pg8::cvt_pk_bf16;
typedef unsigned u32x2 __attribute__((ext_vector_type(2)));
typedef float f32x2 __attribute__((ext_vector_type(2)));
typedef float f32x16 __attribute__((ext_vector_type(16)));

constexpr int BATCH = 2, SEQ = 16384, D = 1024, M = BATCH * SEQ, DFF = 2816, PLE = 256, DEPTH = 4;
constexpr int NQKV = 1536, HIN = 5120;
constexpr float ALPHA = 1.681792830507429f, LN_EPS = 1e-5f, LOG2E = 1.4426950408889634f;
constexpr size_t MiB = (size_t)1 << 20;
constexpr size_t WS_WIN = 0, WS_WOUT = 10 * MiB, WS_W1 = 12 * MiB, WS_W2 = 23 * MiB, WS_WG = 29 * MiB, WS_WP = 31 * MiB, WS_VEC = 31 * MiB + 512 * 1024;
constexpr size_t WS_ST1 = 32 * MiB, WS_ST2 = 36 * MiB, WS_XBX = 40 * MiB, WS_XBY = 104 * MiB, WS_PP = 168 * MiB;
constexpr size_t WS_Q = 248 * MiB, WS_K = 312 * MiB, WS_V = 328 * MiB, WS_O = 344 * MiB, WS_H = 248 * MiB;
constexpr size_t WS_Z = 104 * MiB, WS_SB = 424 * MiB, WS_SF = WS_XBX, WS_PB = 488 * MiB, WS_ROPE = 504 * MiB, WS_LB = 505 * MiB, WS_DEC = 506 * MiB, WS_CTL = 508 * MiB, WS_END = 509 * MiB;
constexpr size_t CTL_ZERO_BYTES = 16384;
constexpr int LDS_BYTES = 147456;
constexpr int REP_SYNC = 1, REP_WCONV = 1, REP_ATT = 1, REP_H1 = 1;

__device__ __forceinline__ float bf_lo(unsigned w) { return __uint_as_float(w << 16); }
__device__ __forceinline__ float bf_hi(unsigned w) { return __uint_as_float(w & 0xffff0000u); }
__device__ __forceinline__ unsigned f2bf(float f) { unsigned u = __float_as_uint(f); return (u + 0x7fffu + ((u >> 16) & 1u)) >> 16; }
__device__ __forceinline__ float sigmoidf_(float x) { return 1.0f / (1.0f + __expf(-x)); }
__device__ __forceinline__ u32x4 pack8(const f32x4 a, const f32x4 b) { u32x4 w; w.x = cvt_pk_bf16(a[0], a[1]); w.y = cvt_pk_bf16(a[2], a[3]); w.z = cvt_pk_bf16(b[0], b[1]); w.w = cvt_pk_bf16(b[2], b[3]); return w; }

__device__ __forceinline__ void load_row_stats(const f32x2* part, int pm, int wr, int fr, int fq, float (&mu)[8], float (&rs)[8]) {
    float mye[2], rse[2];
#pragma unroll
    for (int e = 0; e < 2; ++e) {
        const int row = pm * 256 + (fq >> 1) * 128 + wr * 64 + (2 * (fq & 1) + e) * 16 + fr;
        const f32x4* p = (const f32x4*)(part + (size_t)row * 16);
        float s = 0.f, q = 0.f;
#pragma unroll
        for (int i = 0; i < 8; ++i) { const f32x4 v = p[i]; s += v[0] + v[2]; q += v[1] + v[3]; }
        const float mean = s * (1.0f / 1024.0f); float var = q * (1.0f / 1024.0f) - mean * mean; var = var > 0.f ? var : 0.f;
        mye[e] = mean; rse[e] = 1.0f / sqrtf(var + LN_EPS);
    }
#pragma unroll
    for (int ai = 0; ai < 2; ++ai)
#pragma unroll
        for (int m = 0; m < 4; ++m) { const int src = fr + 16 * (ai * 2 + (m >> 1)); mu[ai * 4 + m] = __shfl(mye[m & 1], src); rs[ai * 4 + m] = __shfl(rse[m & 1], src); }
}

struct EpiPlain {
    static constexpr bool PERM = true, AFTER_DRAIN = false;
    bf16_t* O; int ldc;
    __device__ __forceinline__ void operator()(const f32x4 (&acc)[2][2][4][2], const Unit& u, int wr, int wc, int fr, int fq) const {
        const int row0 = u.pm * 256 + wr * 64 + fr, col0 = u.pn * 256 + wc * 32 + 8 * fq;
#pragma unroll
        for (int ai = 0; ai < 2; ++ai)
#pragma unroll
            for (int m = 0; m < 4; ++m) { bf16_t* rowp = O + (size_t)(row0 + ai * 128 + m * 16) * ldc + col0;
#pragma unroll
                for (int bj = 0; bj < 2; ++bj) *(u32x4*)(rowp + bj * 128) = pack8(acc[ai][bj][m][0], acc[ai][bj][m][1]); }
    }
};

struct EpiQKV {
    static constexpr bool PERM = true, AFTER_DRAIN = false;
    bf16_t *Q, *K, *V; const float* rope;
    __device__ __forceinline__ void operator()(const f32x4 (&acc)[2][2][4][2], const Unit& u, int wr, int wc, int fr, int fq) const {
        bf16_t* base; int ldc, colt; float sc;
        if (u.pn < 4) { base = Q; ldc = 1024; colt = u.pn * 256; sc = 0.125f * LOG2E; } else if (u.pn == 4) { base = K; ldc = 256; colt = 0; sc = 1.f; } else { base = V; ldc = 256; colt = 0; sc = 1.f; }
        const bool do_rope = (u.pn < 5) && ((wc & 1) == 0) && (fq < 2);
        const int col0 = colt + wc * 32 + 8 * fq;
#pragma unroll
        for (int ai = 0; ai < 2; ++ai)
#pragma unroll
            for (int m = 0; m < 4; ++m) {
                const int row = u.pm * 256 + ai * 128 + wr * 64 + m * 16 + fr, pos = row & (SEQ - 1);
                f32x4 c4 = {1.f, 1.f, 1.f, 1.f}, s4 = {0.f, 0.f, 0.f, 0.f};
                if (do_rope) { c4 = *(const f32x4*)(rope + (size_t)pos * 8 + 4 * fq); s4 = *(const f32x4*)(rope + (size_t)SEQ * 8 + (size_t)pos * 8 + 4 * fq); }
#pragma unroll
                for (int bj = 0; bj < 2; ++bj) {
                    f32x4 v0 = acc[ai][bj][m][0], v1 = acc[ai][bj][m][1];
                    if (do_rope) {
                        f32x4 r0, r1;
                        r0[0] = v0[0] * c4[0] - v0[1] * s4[0]; r0[1] = v0[1] * c4[0] + v0[0] * s4[0];
                        r0[2] = v0[2] * c4[1] - v0[3] * s4[1]; r0[3] = v0[3] * c4[1] + v0[2] * s4[1];
                        r1[0] = v1[0] * c4[2] - v1[1] * s4[2]; r1[1] = v1[1] * c4[2] + v1[0] * s4[2];
                        r1[2] = v1[2] * c4[3] - v1[3] * s4[3]; r1[3] = v1[3] * c4[3] + v1[2] * s4[3];
                        v0 = r0; v1 = r1;
                    }
                    v0 = v0 * sc; v1 = v1 * sc;
                    *(u32x4*)(base + (size_t)row * ldc + col0 + bj * 128) = pack8(v0, v1);
                }
            }
    }
};

struct EpiHin {
    static constexpr bool PERM = true, AFTER_DRAIN = false;
    bf16_t* Z; const float* lb;
    __device__ __forceinline__ void operator()(const f32x4 (&acc)[2][2][4][2], const Unit& u, int wr, int wc, int fr, int fq) const {
        const int seg = u.pn >> 2, col0 = u.pn * 256 + wc * 32 + 8 * fq;
#pragma unroll
        for (int bj = 0; bj < 2; ++bj) {
            f32x4 l0 = {0.f, 0.f, 0.f, 0.f}, l1 = l0;
            if (seg == 1 || seg == 2) { const float* lp = lb + (col0 + bj * 128 - 1024); l0 = *(const f32x4*)lp; l1 = *(const f32x4*)(lp + 4); }
#pragma unroll
            for (int ai = 0; ai < 2; ++ai)
#pragma unroll
                for (int m = 0; m < 4; ++m) {
                    const int row = u.pm * 256 + ai * 128 + wr * 64 + m * 16 + fr;
                    f32x4 v0 = acc[ai][bj][m][0], v1 = acc[ai][bj][m][1];
                    if (seg == 0 || seg == 4) {
#pragma unroll
                        for (int i = 0; i < 4; ++i) { v0[i] = v0[i] * sigmoidf_(v0[i]); v1[i] = v1[i] * sigmoidf_(v1[i]); }
                    } else if (seg == 1 || seg == 2) {
#pragma unroll
                        for (int i = 0; i < 4; ++i) { v0[i] = __logf(l0[i] + (1.f - l0[i]) * sigmoidf_(v0[i])); v1[i] = __logf(l1[i] + (1.f - l1[i]) * sigmoidf_(v1[i])); }
                    }
                    *(u32x4*)(Z + (size_t)row * HIN + col0 + bj * 128) = pack8(v0, v1);
                }
        }
    }
};

template <bool LNRES> struct EpiRes {
    static constexpr bool PERM = true, AFTER_DRAIN = false;
    const float* resid; float* out; bf16_t* xb; f32x2* part_out; const f32x2* part_in; const float* g; const float* b;
    __device__ __forceinline__ void operator()(const f32x4 (&acc)[2][2][4][2], const Unit& u, int wr, int wc, int fr, int fq) const {
        float mu[8], rs[8];
        if (LNRES) load_row_stats(part_in, u.pm, wr, fr, fq, mu, rs);
        const int col0 = u.pn * 256 + wc * 32 + 8 * fq;
        float ss[8], qq[8];
#pragma unroll
        for (int i = 0; i < 8; ++i) { ss[i] = 0.f; qq[i] = 0.f; }
#pragma unroll
        for (int bj = 0; bj < 2; ++bj) {
            f32x4 g0, g1, b0, b1;
            if (LNRES) { g0 = *(const f32x4*)(g + col0 + bj * 128); g1 = *(const f32x4*)(g + col0 + bj * 128 + 4); b0 = *(const f32x4*)(b + col0 + bj * 128); b1 = *(const f32x4*)(b + col0 + bj * 128 + 4); }
#pragma unroll
            for (int ai = 0; ai < 2; ++ai)
#pragma unroll
                for (int m = 0; m < 4; ++m) {
                    const int row = u.pm * 256 + ai * 128 + wr * 64 + m * 16 + fr; const size_t off = (size_t)row * D + col0 + bj * 128;
                    f32x4 r0 = *(const f32x4*)(resid + off), r1 = *(const f32x4*)(resid + off + 4);
                    if (LNRES) { const float mm = mu[ai * 4 + m], rr = rs[ai * 4 + m]; r0 = (r0 - mm) * rr * g0 + b0; r1 = (r1 - mm) * rr * g1 + b1; }
                    const f32x4 y0 = r0 * ALPHA + acc[ai][bj][m][0], y1 = r1 * ALPHA + acc[ai][bj][m][1];
                    *(f32x4*)(out + off) = y0; *(f32x4*)(out + off + 4) = y1;
                    *(u32x4*)(xb + off) = pack8(y0, y1);
                    ss[ai * 4 + m] += (y0[0] + y0[1]) + (y0[2] + y0[3]) + (y1[0] + y1[1]) + (y1[2] + y1[3]);
                    qq[ai * 4 + m] += (y0[0] * y0[0] + y0[1] * y0[1]) + (y0[2] * y0[2] + y0[3] * y0[3]) + (y1[0] * y1[0] + y1[1] * y1[1]) + (y1[2] * y1[2] + y1[3] * y1[3]);
                }
        }
#pragma unroll
        for (int ai = 0; ai < 2; ++ai)
#pragma unroll
            for (int m = 0; m < 4; ++m) {
                float s = ss[ai * 4 + m], q = qq[ai * 4 + m];
                s += __shfl_xor(s, 16); s += __shfl_xor(s, 32); q += __shfl_xor(q, 16); q += __shfl_xor(q, 32);
                const int row = u.pm * 256 + ai * 128 + wr * 64 + m * 16 + fr;
                if (fq == 0) part_out[(size_t)row * 16 + u.pn * 4 + wc] = (f32x2){s, q};
            }
    }
};

struct EpiFfn1 {
    static constexpr bool PERM = true, AFTER_DRAIN = false;
    bf16_t* H; const f32x2* part; const float* cs; const float* bw;
    __device__ __forceinline__ void operator()(const f32x4 (&acc)[2][2][4][2], const Unit& u, int wr, int wc, int fr, int fq) const {
        float mu[8], rs[8];
        load_row_stats(part, u.pm, wr, fr, fq, mu, rs);
        const int col0 = u.pn * 256 + wc * 32 + 8 * fq, hcol0 = u.pn * 128 + wc * 16 + 4 * fq;
#pragma unroll
        for (int bj = 0; bj < 2; ++bj) {
            const f32x4 c0 = *(const f32x4*)(cs + col0 + bj * 128), c1 = *(const f32x4*)(cs + col0 + bj * 128 + 4), w0 = *(const f32x4*)(bw + col0 + bj * 128), w1 = *(const f32x4*)(bw + col0 + bj * 128 + 4);
#pragma unroll
            for (int ai = 0; ai < 2; ++ai)
#pragma unroll
                for (int m = 0; m < 4; ++m) {
                    const int row = u.pm * 256 + ai * 128 + wr * 64 + m * 16 + fr; const float mm = mu[ai * 4 + m], rr = rs[ai * 4 + m];
                    const f32x4 v0 = (acc[ai][bj][m][0] - c0 * mm) * rr + w0, v1 = (acc[ai][bj][m][1] - c1 * mm) * rr + w1;
                    const float h0 = v0[0] * sigmoidf_(v0[0]) * v0[1], h1 = v0[2] * sigmoidf_(v0[2]) * v0[3], h2 = v1[0] * sigmoidf_(v1[0]) * v1[1], h3 = v1[2] * sigmoidf_(v1[2]) * v1[3];
                    u32x2 w; w.x = cvt_pk_bf16(h0, h1); w.y = cvt_pk_bf16(h2, h3);
                    *(u32x2*)(H + (size_t)row * DFF + hcol0 + bj * 64) = w;
                }
        }
    }
};

struct EpiPle {
    static constexpr bool PERM = true, AFTER_DRAIN = false;
    float* out; bf16_t* xb; const f32x2* part; const float *g, *b, *cs, *bw; const bf16_t* pp;
    __device__ __forceinline__ void operator()(const f32x4 (&acc)[2][2][4][2], const Unit& u, int wr, int wc, int fr, int fq) const {
        float mu[8], rs[8];
        load_row_stats(part, u.pm, wr, fr, fq, mu, rs);
        const int col0 = u.pn * 256 + wc * 32 + 8 * fq;
#pragma unroll
        for (int bj = 0; bj < 2; ++bj) {
            const int cc = col0 + bj * 128;
            const f32x4 g0 = *(const f32x4*)(g + cc), g1 = *(const f32x4*)(g + cc + 4), b0 = *(const f32x4*)(b + cc), b1 = *(const f32x4*)(b + cc + 4);
            const f32x4 c0 = *(const f32x4*)(cs + cc), c1 = *(const f32x4*)(cs + cc + 4), w0 = *(const f32x4*)(bw + cc), w1 = *(const f32x4*)(bw + cc + 4);
#pragma unroll
            for (int ai = 0; ai < 2; ++ai)
#pragma unroll
                for (int m = 0; m < 4; ++m) {
                    const int row = u.pm * 256 + ai * 128 + wr * 64 + m * 16 + fr; const size_t off = (size_t)row * D + cc; const float mm = mu[ai * 4 + m], rr = rs[ai * 4 + m];
                    const f32x4 y0 = *(const f32x4*)(out + off), y1 = *(const f32x4*)(out + off + 4);
                    const u32x4 pw = *(const u32x4*)(pp + off);
                    const f32x4 p0 = {bf_lo(pw.x), bf_hi(pw.x), bf_lo(pw.y), bf_hi(pw.y)}, p1 = {bf_lo(pw.z), bf_hi(pw.z), bf_lo(pw.w), bf_hi(pw.w)};
                    f32x4 t0 = (acc[ai][bj][m][0] - c0 * mm) * rr + w0, t1 = (acc[ai][bj][m][1] - c1 * mm) * rr + w1;
#pragma unroll
                    for (int i = 0; i < 4; ++i) { t0[i] = sigmoidf_(t0[i]); t1[i] = sigmoidf_(t1[i]); }
                    const f32x4 x0 = (y0 - mm) * rr * g0 + b0 + t0 * p0, x1 = (y1 - mm) * rr * g1 + b1 + t1 * p1;
                    *(f32x4*)(out + off) = x0; *(f32x4*)(out + off + 4) = x1;
                    *(u32x4*)(xb + off) = pack8(x0, x1);
                }
        }
    }
};

template <int MODE, bool FOLD>
__device__ __forceinline__ void conv_item(const float* W, int K, int N, bf16_t* Bt, int n0, int k0, int klen, const float* g, const float* bvec, float* cs, float* bw, float* scr, int lane) {
    const int np = n0 + (lane & 31); int src = np;
    if (MODE == 1) { if (np < 1280) { const int hp = np & 63; if (hp < 16) src = (np & ~63) + (hp >> 1) + 8 * (hp & 1); } }
    if (MODE == 2) { const int t = np >> 8, w = np & 255; src = (w & 1) * DFF + t * 128 + (w >> 1); }
    float csacc = 0.f, bacc = 0.f;
    for (int ks = k0; ks < k0 + klen; ks += 64) {
#pragma unroll 8
        for (int i = 0; i < 32; ++i) {
            const int kk = 2 * i + (lane >> 5);
            float w = W[(size_t)(ks + kk) * N + src];
            if (FOLD) { bacc += bvec[ks + kk] * w; w *= g[ks + kk]; }
            const float r = __uint_as_float(f2bf(w) << 16);
            if (FOLD) csacc += r;
            scr[kk * 33 + (lane & 31)] = r;
        }
        asm volatile("s_waitcnt lgkmcnt(0)" ::: "memory");
        const int c = lane & 7;
#pragma unroll
        for (int j = 0; j < 4; ++j) {
            const int n = (lane >> 3) + 8 * j; const float* s = scr + (8 * c) * 33 + n;
            u32x4 o; o.x = cvt_pk_bf16(s[0 * 33], s[1 * 33]); o.y = cvt_pk_bf16(s[2 * 33], s[3 * 33]); o.z = cvt_pk_bf16(s[4 * 33], s[5 * 33]); o.w = cvt_pk_bf16(s[6 * 33], s[7 * 33]);
            *(u32x4*)(Bt + (size_t)(n0 + n) * K + ks + 8 * c) = o;
        }
        asm volatile("s_waitcnt lgkmcnt(0)" ::: "memory");
    }
    if (FOLD) {
        csacc += __shfl_xor(csacc, 32); bacc += __shfl_xor(bacc, 32);
        if (lane < 32) { cs[np] = csacc; bw[np] = bacc; }
    }
}

__device__ __forceinline__ void cvt_f32_bf16(const float* src, bf16_t* dst, size_t n, size_t gt, size_t GT) {
    for (size_t i = gt * 8; i < n; i += GT * 8) { const f32x4 a = *(const f32x4*)(src + i), b = *(const f32x4*)(src + i + 4); *(u32x4*)(dst + i) = pack8(a, b); }
}

struct Ptrs {
    const float *x, *p, *att_wqkv, *att_sink, *att_wo, *hg_win, *hg_lb, *hg_ng, *hg_wo, *lnm_g, *lnm_b, *ffn_win, *ffn_wout, *lnf_g, *lnf_b, *ple_wg, *ple_wp;
    float* out; unsigned char* ws;
};

typedef const Ptrs __attribute__((address_space(4)))* KP;
__device__ __forceinline__ void wconv_phase(KP Pk, int L, unsigned char* lds, int G, int blk) {
#define P (*Pk)
    int tid_l = threadIdx.x; asm volatile("" : "+v"(tid_l)); const int tid = tid_l, lane = tid & 63, wid = tid >> 6, j = L >> 1; const bool att = (L & 1) == 0;
    float* scr = (float*)(lds + wid * 16384);
    unsigned char* ws = P.ws;
    bf16_t *WIN = (bf16_t*)(ws + WS_WIN), *WOUT = (bf16_t*)(ws + WS_WOUT), *W1 = (bf16_t*)(ws + WS_W1), *W2 = (bf16_t*)(ws + WS_W2), *WG = (bf16_t*)(ws + WS_WG), *WP = (bf16_t*)(ws + WS_WP);
    float* vec = (float*)(ws + WS_VEC);
    const int nin = att ? NQKV / 32 : HIN / 32;
    const int I0 = nin, I1 = I0 + 32, I2 = I1 + 176, I3 = I2 + 128, I4 = I3 + 32, I5 = I4 + 32;
    for (int it = wid * G + blk; it < I5; it += 8 * G) {
        if (it < I0) { if (att) conv_item<1, false>(P.att_wqkv + (size_t)j * D * NQKV, D, NQKV, WIN, it * 32, 0, D, nullptr, nullptr, nullptr, nullptr, scr, lane);
                       else conv_item<0, false>(P.hg_win + (size_t)j * D * HIN, D, HIN, WIN, it * 32, 0, D, nullptr, nullptr, nullptr, nullptr, scr, lane); }
        else if (it < I1) conv_item<0, false>((att ? P.att_wo : P.hg_wo) + (size_t)j * D * D, D, D, WOUT, (it - I0) * 32, 0, D, nullptr, nullptr, nullptr, nullptr, scr, lane);
        else if (it < I2) conv_item<2, true>(P.ffn_win + (size_t)L * D * 2 * DFF, D, 2 * DFF, W1, (it - I1) * 32, 0, D, P.lnm_g + L * D, P.lnm_b + L * D, vec, vec + 5632, scr, lane);
        else if (it < I3) { const int r = it - I2; conv_item<0, false>(P.ffn_wout + (size_t)L * DFF * D, DFF, D, W2, (r >> 2) * 32, (r & 3) * 704, 704, nullptr, nullptr, nullptr, nullptr, scr, lane); }
        else if (it < I4) conv_item<0, true>(P.ple_wg + (size_t)L * D * D, D, D, WG, (it - I3) * 32, 0, D, P.lnf_g + L * D, P.lnf_b + L * D, vec + 11264, vec + 12288, scr, lane);
        else conv_item<0, false>(P.ple_wp + (size_t)L * PLE * D, PLE, D, WP, (it - I4) * 32, 0, PLE, nullptr, nullptr, nullptr, nullptr, scr, lane);
    }
    const size_t gt = (size_t)blk * 512 + tid, GT = (size_t)G * 512;
    cvt_f32_bf16(P.p + (size_t)L * M * PLE, (bf16_t*)(ws + WS_PB), (size_t)M * PLE, gt, GT);
    if (L == 0) {
        cvt_f32_bf16(P.x, (bf16_t*)(ws + WS_XBX), (size_t)M * D, gt, GT);
        float* rope = (float*)(ws + WS_ROPE);
        for (size_t i = gt; i < (size_t)SEQ * 8; i += GT) {
            const int pos = (int)(i >> 3), fi = (int)(i & 7);
            const float invs[8] = {1.0f, 0x1.8d275ep-3f, 0x1.34119p-5f, 0x1.ddee9cp-8f, 0x1.72ba44p-10f, 0x1.1f91fp-12f, 0x1.be218ap-15f, 0x1.5a0f5p-17f};
            float inv = invs[0];
#pragma unroll
            for (int q = 1; q < 8; ++q) inv = (fi == q) ? invs[q] : inv;
            const float ang = (float)pos * inv;
            const double rev = (double)ang * 0.15915494309189535; const double fr = rev - __builtin_rint(rev);
            const float x = (float)fr;
            rope[i] = __builtin_amdgcn_cosf(x); rope[(size_t)SEQ * 8 + i] = __builtin_amdgcn_sinf(x);
        }
    }
    if (!att) {
        float* lb = (float*)(ws + WS_LB);
        for (size_t i = gt; i < 2048; i += GT) {
            float v[4], mx = -1e30f;
#pragma unroll
            for (int d = 0; d < 4; ++d) { v[d] = P.hg_lb[(size_t)d * 2048 + i]; mx = fmaxf(mx, v[d]); }
            float den = 0.f, num = 0.f;
#pragma unroll
            for (int d = 0; d < 4; ++d) { const float e = __expf(v[d] - mx); den += e; if (d >= 1 && d <= L) num += e; }
            lb[i] = num / den;
        }
    }
#undef P
}

__device__ __forceinline__ int crow(int r, int hi) { return (r & 3) + 8 * (r >> 2) + 4 * hi; }
__device__ __forceinline__ void attn_phase(unsigned char* lds, const bf16_t* Q, const bf16_t* Kb, const bf16_t* Vb, bf16_t* O, const float* sink, int G, int blk) {
    int tid_l = threadIdx.x; asm volatile("" : "+v"(tid_l)); const int tid = tid_l, lane = tid & 63, wid = tid >> 6, r32 = lane & 31, hi = lane >> 5;
    bf16_t* Ks = (bf16_t*)lds; bf16_t* Vt = (bf16_t*)(lds + 384 * 72 * 2);
    for (int unit = blk; unit < 1024; unit += G) {
        const int b = unit >> 9, kvh = (unit >> 7) & 3, qb = unit & 127, start = qb * 128;
        __syncthreads();
        for (int idx = tid; idx < 384 * 8; idx += 512) {
            const int key = idx >> 3, ch = idx & 7, kpos = start - 128 + key;
            if (kpos >= 0 && kpos < SEQ) {
                const size_t gofs = ((size_t)(b * SEQ + kpos)) * 256 + kvh * 64 + ch * 8;
                const u32x4 kv = *(const u32x4*)(Kb + gofs); *(u32x4*)(Ks + key * 72 + ch * 8) = kv;
                const u32x4 vv = *(const u32x4*)(Vb + gofs);
#pragma unroll
                for (int jj = 0; jj < 4; ++jj) { const unsigned w = vv[jj]; Vt[(ch * 8 + 2 * jj) * 392 + key] = (bf16_t)(w & 0xffffu); Vt[(ch * 8 + 2 * jj + 1) * 392 + key] = (bf16_t)(w >> 16); }
            }
        }
        __syncthreads();
        const int g = wid >> 1, half = wid & 1, head = kvh * 4 + g;
        const float sk = sink[head] * LOG2E;
        for (int sb = 0; sb < 2; ++sb) {
            const int r0 = 64 * half + 32 * sb; const size_t tok = (size_t)b * SEQ + start + r0 + r32;
            bf16x8 qf[4];
#pragma unroll
            for (int ks = 0; ks < 4; ++ks) qf[ks] = *(const bf16x8*)(Q + tok * 1024 + head * 64 + 16 * ks + 8 * hi);
            float m = sk, l = 1.f; f32x16 o0 = {}, o1 = {};
            for (int j = 0; j < 9; ++j) {
                const int key0 = r0 + 32 * j, kpos0 = start - 128 + key0;
                if (kpos0 < 0 || kpos0 >= SEQ) continue;
                f32x16 s = {};
#pragma unroll
                for (int ks = 0; ks < 4; ++ks) { const bf16x8 a = *(const bf16x8*)(Ks + (key0 + r32) * 72 + 16 * ks + 8 * hi); s = __builtin_amdgcn_mfma_f32_32x32x16_bf16(a, qf[ks], s, 0, 0, 0); }
                if (j == 0) {
#pragma unroll
                    for (int r = 0; r < 16; ++r) if (crow(r, hi) < r32) s[r] = -INFINITY;
                }
                if (j == 8) {
#pragma unroll
                    for (int r = 0; r < 16; ++r) if (crow(r, hi) > r32) s[r] = -INFINITY;
                }
                float mx = s[0];
#pragma unroll
                for (int r = 1; r < 16; ++r) mx = fmaxf(mx, s[r]);
                mx = fmaxf(mx, __shfl_xor(mx, 32));
                const float mn = fmaxf(m, mx), al = __builtin_amdgcn_exp2f(m - mn);
                float rsum = 0.f;
#pragma unroll
                for (int r = 0; r < 16; ++r) { s[r] = __builtin_amdgcn_exp2f(s[r] - mn); rsum += s[r]; }
                rsum += __shfl_xor(rsum, 32);
                l = l * al + rsum; m = mn;
#pragma unroll
                for (int r = 0; r < 16; ++r) { o0[r] *= al; o1[r] *= al; }
                bf16x8 pf[2];
#pragma unroll
                for (int s2 = 0; s2 < 2; ++s2) { u32x4 w; w.x = cvt_pk_bf16(s[8 * s2 + 0], s[8 * s2 + 1]); w.y = cvt_pk_bf16(s[8 * s2 + 2], s[8 * s2 + 3]); w.z = cvt_pk_bf16(s[8 * s2 + 4], s[8 * s2 + 5]); w.w = cvt_pk_bf16(s[8 * s2 + 6], s[8 * s2 + 7]); pf[s2] = __builtin_bit_cast(bf16x8, w); }
#pragma unroll
                for (int s2 = 0; s2 < 2; ++s2) {
                    const bf16_t* v0 = Vt + r32 * 392 + key0 + 16 * s2 + 4 * hi;
                    const u32x2 a0 = *(const u32x2*)v0, a1 = *(const u32x2*)(v0 + 8);
                    const u32x2 c0 = *(const u32x2*)(v0 + 32 * 392), c1 = *(const u32x2*)(v0 + 32 * 392 + 8);
                    const u32x4 A0 = {a0.x, a0.y, a1.x, a1.y}, A1 = {c0.x, c0.y, c1.x, c1.y};
                    o0 = __builtin_amdgcn_mfma_f32_32x32x16_bf16(__builtin_bit_cast(bf16x8, A0), pf[s2], o0, 0, 0, 0);
                    o1 = __builtin_amdgcn_mfma_f32_32x32x16_bf16(__builtin_bit_cast(bf16x8, A1), pf[s2], o1, 0, 0, 0);
                }
            }
            const float inv = 1.0f / l;
            bf16_t* op = O + tok * 1024 + head * 64 + 4 * hi;
#pragma unroll
            for (int g4 = 0; g4 < 4; ++g4) {
                u32x2 w0, w1;
                w0.x = cvt_pk_bf16(o0[4 * g4] * inv, o0[4 * g4 + 1] * inv); w0.y = cvt_pk_bf16(o0[4 * g4 + 2] * inv, o0[4 * g4 + 3] * inv);
                w1.x = cvt_pk_bf16(o1[4 * g4] * inv, o1[4 * g4 + 1] * inv); w1.y = cvt_pk_bf16(o1[4 * g4 + 2] * inv, o1[4 * g4 + 3] * inv);
                *(u32x2*)(op + 8 * g4) = w0; *(u32x2*)(op + 32 + 8 * g4) = w1;
            }
        }
    }
    __syncthreads();
}

constexpr int HP = 136;
constexpr int L_TOT = 0, L_KO = 4096, L_ST = L_KO + 128 * HP * 2, L_VT = L_ST + 128 * HP * 2, L_P = L_VT + 128 * HP * 2;
static_assert(L_P + 8 * 16 * HP * 2 <= LDS_BYTES, "hgrn lds");
template <int DIR> __device__ __forceinline__ float scan16(float v) {
    if (DIR == 0) {
        v += __int_as_float(__builtin_amdgcn_update_dpp(0, __float_as_int(v), 0x111, 0xf, 0xf, true));
        v += __int_as_float(__builtin_amdgcn_update_dpp(0, __float_as_int(v), 0x112, 0xf, 0xf, true));
        v += __int_as_float(__builtin_amdgcn_update_dpp(0, __float_as_int(v), 0x114, 0xf, 0xf, true));
        v += __int_as_float(__builtin_amdgcn_update_dpp(0, __float_as_int(v), 0x118, 0xf, 0xf, true));
    } else {
        v += __int_as_float(__builtin_amdgcn_update_dpp(0, __float_as_int(v), 0x101, 0xf, 0xf, true));
        v += __int_as_float(__builtin_amdgcn_update_dpp(0, __float_as_int(v), 0x102, 0xf, 0xf, true));
        v += __int_as_float(__builtin_amdgcn_update_dpp(0, __float_as_int(v), 0x104, 0xf, 0xf, true));
        v += __int_as_float(__builtin_amdgcn_update_dpp(0, __float_as_int(v), 0x108, 0xf, 0xf, true));
    }
    return v;
}
__device__ __forceinline__ void load32(const bf16_t* p, float (&v)[32]) {
#pragma unroll
    for (int ks = 0; ks < 4; ++ks) { const u32x4 w = *(const u32x4*)(p + 32 * ks);
        v[8 * ks + 0] = bf_lo(w.x); v[8 * ks + 1] = bf_hi(w.x); v[8 * ks + 2] = bf_lo(w.y); v[8 * ks + 3] = bf_hi(w.y); v[8 * ks + 4] = bf_lo(w.z); v[8 * ks + 5] = bf_hi(w.z); v[8 * ks + 6] = bf_lo(w.w); v[8 * ks + 7] = bf_hi(w.w); }
}
__device__ __forceinline__ bf16x8 pk8(const float* v) { u32x4 w; w.x = cvt_pk_bf16(v[0], v[1]); w.y = cvt_pk_bf16(v[2], v[3]); w.z = cvt_pk_bf16(v[4], v[5]); w.w = cvt_pk_bf16(v[6], v[7]); return __builtin_bit_cast(bf16x8, w); }
#define WAVE_LDS_FENCE() do { asm volatile("s_waitcnt lgkmcnt(0)" ::: "memory"); __builtin_amdgcn_wave_barrier(); } while (0)

template <int DIR> __device__ __forceinline__ void h1_dir(unsigned char* lds, const bf16_t* zrow, int h, bf16_t* slot, float* decp) {
    int tid_l = threadIdx.x; asm volatile("" : "+v"(tid_l)); const int tid = tid_l, lane = tid & 63, wid = tid >> 6, r = lane & 15, kq = lane >> 4;
    float* TOT = (float*)(lds + L_TOT); bf16_t* KS = (bf16_t*)(lds + L_KO); bf16_t* VT = (bf16_t*)(lds + L_VT); bf16_t* STG = (bf16_t*)(lds + L_ST);
    float bl[32], kk[32];
    load32(zrow + 1024 * (1 + DIR) + h * 128 + 8 * kq, bl);
#pragma unroll
    for (int i = 0; i < 32; ++i) { kk[i] = 1.0f - __expf(bl[i]); bl[i] = scan16<DIR>(bl[i]); }
    if (r == (DIR ? 0 : 15)) {
#pragma unroll
        for (int ks = 0; ks < 4; ++ks) { *(f32x4*)(TOT + wid * 128 + 32 * ks + 8 * kq) = (f32x4){bl[8 * ks], bl[8 * ks + 1], bl[8 * ks + 2], bl[8 * ks + 3]}; *(f32x4*)(TOT + wid * 128 + 32 * ks + 8 * kq + 4) = (f32x4){bl[8 * ks + 4], bl[8 * ks + 5], bl[8 * ks + 6], bl[8 * ks + 7]}; }
    }
    __syncthreads();
    {
        float aft[32];
#pragma unroll
        for (int i = 0; i < 32; ++i) aft[i] = 0.f;
        for (int m = 0; m < 8; ++m) {
            const bool use = DIR ? (m <= wid) : (m >= wid);
            if (use) {
#pragma unroll
                for (int ks = 0; ks < 4; ++ks) { const f32x4 a = *(const f32x4*)(TOT + m * 128 + 32 * ks + 8 * kq), b = *(const f32x4*)(TOT + m * 128 + 32 * ks + 8 * kq + 4);
                    aft[8 * ks] += a[0]; aft[8 * ks + 1] += a[1]; aft[8 * ks + 2] += a[2]; aft[8 * ks + 3] += a[3]; aft[8 * ks + 4] += b[0]; aft[8 * ks + 5] += b[1]; aft[8 * ks + 6] += b[2]; aft[8 * ks + 7] += b[3]; }
            }
        }
        if (wid == (DIR ? 7 : 0) && r == 0) {
#pragma unroll
            for (int ks = 0; ks < 4; ++ks)
#pragma unroll
                for (int e = 0; e < 8; ++e) decp[32 * ks + 8 * kq + e] = __expf(aft[8 * ks + e]);
        }
#pragma unroll
        for (int ks = 0; ks < 4; ++ks)
#pragma unroll
            for (int e = 0; e < 8; ++e) KS[(32 * ks + 8 * kq + e) * HP + 16 * wid + r] = (bf16_t)f2bf(kk[8 * ks + e] * __expf(aft[8 * ks + e] - bl[8 * ks + e]));
    }
    __syncthreads();
    f32x4 acc[8];
#pragma unroll
    for (int nt = 0; nt < 8; ++nt) acc[nt] = (f32x4){0.f, 0.f, 0.f, 0.f};
#pragma unroll
    for (int ks = 0; ks < 4; ++ks) {
        const bf16x8 a = *(const bf16x8*)(VT + (16 * wid + r) * HP + 32 * ks + 8 * kq);
#pragma unroll
        for (int nt = 0; nt < 8; ++nt) { const bf16x8 bb = *(const bf16x8*)(KS + (16 * nt + r) * HP + 32 * ks + 8 * kq); acc[nt] = __builtin_amdgcn_mfma_f32_16x16x32_bf16(a, bb, acc[nt], 0, 0, 0); }
    }
#pragma unroll
    for (int nt = 0; nt < 8; ++nt)
#pragma unroll
        for (int i = 0; i < 4; ++i) STG[(16 * wid + 4 * kq + i) * HP + 16 * nt + r] = (bf16_t)f2bf(acc[nt][i]);
    WAVE_LDS_FENCE();
#pragma unroll
    for (int it = 0; it < 4; ++it) { const int p = lane + 64 * it, row = p >> 4, c16 = p & 15; *(u32x4*)(slot + (size_t)(16 * wid + row) * 128 + c16 * 8) = *(const u32x4*)(STG + (16 * wid + row) * HP + c16 * 8); }
    __syncthreads();
}
__device__ __forceinline__ void h1_phase(unsigned char* lds, unsigned char* ws, int G, int blk) {
    int tid_l = threadIdx.x; asm volatile("" : "+v"(tid_l)); const int tid = tid_l, lane = tid & 63, wid = tid >> 6, r = lane & 15, kq = lane >> 4;
    const bf16_t* Z = (const bf16_t*)(ws + WS_Z); bf16_t* VT = (bf16_t*)(lds + L_VT);
    for (int unit = blk; unit < 2048; unit += G) {
        const int b = unit >> 10, c = (unit >> 3) & 127, h = unit & 7, chain = b * 8 + h;
        const bf16_t* zrow = Z + ((size_t)b * SEQ + c * 128 + 16 * wid + r) * HIN;
        { float vv[32]; load32(zrow + 3072 + h * 128 + 8 * kq, vv);
#pragma unroll
          for (int ks = 0; ks < 4; ++ks)
#pragma unroll
              for (int e = 0; e < 8; ++e) VT[(32 * ks + 8 * kq + e) * HP + 16 * wid + r] = (bf16_t)(__float_as_uint(vv[8 * ks + e]) >> 16); }
        h1_dir<0>(lds, zrow, h, (bf16_t*)(ws + WS_SF) + ((size_t)chain * 128 + c) * 16384, (float*)(ws + WS_DEC) + ((size_t)(0 * 16 + chain) * 128 + c) * 128);
        h1_dir<1>(lds, zrow, h, (bf16_t*)(ws + WS_SB) + ((size_t)chain * 128 + c) * 16384, (float*)(ws + WS_DEC) + ((size_t)(1 * 16 + chain) * 128 + c) * 128);
    }
}
__device__ __forceinline__ void h2_phase(unsigned char* ws, int G, int blk) {
    int tid_l = threadIdx.x; asm volatile("" : "+v"(tid_l));
    const size_t gt = (size_t)blk * 512 + tid_l, GT = (size_t)G * 512;
    for (size_t w = gt; w < (size_t)32 * 4096; w += GT) {
        const int ch32 = (int)(w >> 12), dir = ch32 >> 4, chain = ch32 & 15, e4 = (int)(w & 4095);
        bf16_t* base = (bf16_t*)(ws + (dir ? WS_SB : WS_SF)) + (size_t)chain * 128 * 16384 + (size_t)e4 * 4;
        const float* dbase = (const float*)(ws + WS_DEC) + ((size_t)(dir * 16 + chain) * 128) * 128 + ((e4 * 4) & 127);
        f32x4 S = {0.f, 0.f, 0.f, 0.f};
        for (int s0 = 0; s0 < 128; s0 += 8) {
            u32x2 raw[8]; f32x4 dd[8];
#pragma unroll
            for (int k = 0; k < 8; ++k) { const int c = dir ? 127 - (s0 + k) : (s0 + k); raw[k] = *(const u32x2*)(base + (size_t)c * 16384); dd[k] = *(const f32x4*)(dbase + (size_t)c * 128); }
#pragma unroll
            for (int k = 0; k < 8; ++k) { const int c = dir ? 127 - (s0 + k) : (s0 + k);
                u32x2 o; o.x = cvt_pk_bf16(S[0], S[1]); o.y = cvt_pk_bf16(S[2], S[3]); *(u32x2*)(base + (size_t)c * 16384) = o;
                const f32x4 ds = {bf_lo(raw[k].x), bf_hi(raw[k].x), bf_lo(raw[k].y), bf_hi(raw[k].y)}; S = dd[k] * S + ds; }
        }
    }
}
template <int DIR> __device__ __forceinline__ void h3_dir(unsigned char* lds, const bf16_t* zrow, int h, const bf16_t* slot, f32x4 (&o)[8]) {
    int tid_l = threadIdx.x; asm volatile("" : "+v"(tid_l)); const int tid = tid_l, lane = tid & 63, wid = tid >> 6, r = lane & 15, kq = lane >> 4;
    float* TOT = (float*)(lds + L_TOT); bf16_t* KO = (bf16_t*)(lds + L_KO); bf16_t* ST = (bf16_t*)(lds + L_ST); const bf16_t* VT = (const bf16_t*)(lds + L_VT); bf16_t* Pw = (bf16_t*)(lds + L_P) + wid * 16 * HP;
    float bl[32], qin[32]; bf16x8 kin[4];
    load32(zrow + 1024 * (1 + DIR) + h * 128 + 8 * kq, bl);
    load32(zrow + h * 128 + 8 * kq, qin);
    {
        float kk[32];
#pragma unroll
        for (int i = 0; i < 32; ++i) { kk[i] = 1.0f - __expf(bl[i]); bl[i] = scan16<DIR>(bl[i]); }
        if (r == (DIR ? 0 : 15)) {
#pragma unroll
            for (int ks = 0; ks < 4; ++ks) { *(f32x4*)(TOT + wid * 128 + 32 * ks + 8 * kq) = (f32x4){bl[8 * ks], bl[8 * ks + 1], bl[8 * ks + 2], bl[8 * ks + 3]}; *(f32x4*)(TOT + wid * 128 + 32 * ks + 8 * kq + 4) = (f32x4){bl[8 * ks + 4], bl[8 * ks + 5], bl[8 * ks + 6], bl[8 * ks + 7]}; }
        }
#pragma unroll
        for (int it = 0; it < 4; ++it) { const int p = tid + 512 * it, v = p >> 4, c16 = p & 15; *(u32x4*)(ST + v * HP + c16 * 8) = *(const u32x4*)(slot + (size_t)v * 128 + c16 * 8); }
#pragma unroll
        for (int it = 0; it < 4; ++it) { const int p = lane + 64 * it; *(u32x4*)(Pw + (p >> 4) * HP + (p & 15) * 8) = (u32x4){0u, 0u, 0u, 0u}; }
        __syncthreads();
        float tmp[8];
#pragma unroll
        for (int ks = 0; ks < 4; ++ks) {
            const f32x4 a = *(const f32x4*)(TOT + wid * 128 + 32 * ks + 8 * kq), b = *(const f32x4*)(TOT + wid * 128 + 32 * ks + 8 * kq + 4);
            const float tw[8] = {a[0], a[1], a[2], a[3], b[0], b[1], b[2], b[3]};
#pragma unroll
            for (int e = 0; e < 8; ++e) tmp[e] = kk[8 * ks + e] * __expf(tw[e] - bl[8 * ks + e]);
            *(bf16x8*)(KO + (16 * wid + r) * HP + 32 * ks + 8 * kq) = pk8(tmp);
#pragma unroll
            for (int e = 0; e < 8; ++e) tmp[e] = kk[8 * ks + e] * __expf(fminf(-bl[8 * ks + e], 80.f));
            kin[ks] = pk8(tmp);
        }
#pragma unroll
        for (int i = 0; i < 32; ++i) qin[i] *= __expf(bl[i]);
    }
    __syncthreads();
    {
        f32x4 sc = {0.f, 0.f, 0.f, 0.f};
#pragma unroll
        for (int ks = 0; ks < 4; ++ks) sc = __builtin_amdgcn_mfma_f32_16x16x32_bf16(pk8(qin + 8 * ks), kin[ks], sc, 0, 0, 0);
#pragma unroll
        for (int i = 0; i < 4; ++i) { const int t = 4 * kq + i; const bool keep = DIR ? (r >= t) : (r <= t); Pw[t * HP + 16 * wid + r] = (bf16_t)f2bf(keep ? sc[i] : 0.f); }
    }
    float run[32];
#pragma unroll
    for (int i = 0; i < 32; ++i) run[i] = 0.f;
    for (int d = 1; d < 8; ++d) {
        const int m = DIR ? wid + d : wid - d;
        if (m < 0 || m > 7) break;
        f32x4 sc = {0.f, 0.f, 0.f, 0.f};
#pragma unroll
        for (int ks = 0; ks < 4; ++ks) {
            float tmp[8];
#pragma unroll
            for (int e = 0; e < 8; ++e) tmp[e] = qin[8 * ks + e] * __expf(run[8 * ks + e]);
            const bf16x8 bb = *(const bf16x8*)(KO + (16 * m + r) * HP + 32 * ks + 8 * kq);
            sc = __builtin_amdgcn_mfma_f32_16x16x32_bf16(pk8(tmp), bb, sc, 0, 0, 0);
            const f32x4 a = *(const f32x4*)(TOT + m * 128 + 32 * ks + 8 * kq), b = *(const f32x4*)(TOT + m * 128 + 32 * ks + 8 * kq + 4);
            run[8 * ks] += a[0]; run[8 * ks + 1] += a[1]; run[8 * ks + 2] += a[2]; run[8 * ks + 3] += a[3]; run[8 * ks + 4] += b[0]; run[8 * ks + 5] += b[1]; run[8 * ks + 6] += b[2]; run[8 * ks + 7] += b[3];
        }
#pragma unroll
        for (int i = 0; i < 4; ++i) Pw[(4 * kq + i) * HP + 16 * m + r] = (bf16_t)f2bf(sc[i]);
    }
#pragma unroll
    for (int i = 0; i < 32; ++i) qin[i] *= __expf(run[i]);
    WAVE_LDS_FENCE();
#pragma unroll
    for (int ks = 0; ks < 4; ++ks) {
        const bf16x8 aq = pk8(qin + 8 * ks), ap = *(const bf16x8*)(Pw + r * HP + 32 * ks + 8 * kq);
#pragma unroll
        for (int nt = 0; nt < 8; ++nt) {
            o[nt] = __builtin_amdgcn_mfma_f32_16x16x32_bf16(aq, *(const bf16x8*)(ST + (16 * nt + r) * HP + 32 * ks + 8 * kq), o[nt], 0, 0, 0);
            o[nt] = __builtin_amdgcn_mfma_f32_16x16x32_bf16(ap, *(const bf16x8*)(VT + (16 * nt + r) * HP + 32 * ks + 8 * kq), o[nt], 0, 0, 0);
        }
    }
    __syncthreads();
}
__device__ __forceinline__ void h3_phase(unsigned char* lds, unsigned char* ws, const float* norm_g, int G, int blk) {
    int tid_l = threadIdx.x; asm volatile("" : "+v"(tid_l)); const int tid = tid_l, lane = tid & 63, wid = tid >> 6, r = lane & 15, kq = lane >> 4;
    bf16_t* Z = (bf16_t*)(ws + WS_Z); bf16_t* VT = (bf16_t*)(lds + L_VT); float* STGF = (float*)(lds + L_KO) + wid * 16 * 132;
    for (int unit = blk; unit < 2048; unit += G) {
        const int b = unit >> 10, c = (unit >> 3) & 127, h = unit & 7, chain = b * 8 + h;
        const size_t tok0 = (size_t)b * SEQ + c * 128 + 16 * wid;
        const bf16_t* zrow = Z + (tok0 + r) * HIN;
        { float vv[32]; load32(zrow + 3072 + h * 128 + 8 * kq, vv);
#pragma unroll
          for (int ks = 0; ks < 4; ++ks)
#pragma unroll
              for (int e = 0; e < 8; ++e) VT[(32 * ks + 8 * kq + e) * HP + 16 * wid + r] = (bf16_t)(__float_as_uint(vv[8 * ks + e]) >> 16); }
        f32x4 o[8];
#pragma unroll
        for (int nt = 0; nt < 8; ++nt) o[nt] = (f32x4){0.f, 0.f, 0.f, 0.f};
        h3_dir<0>(lds, zrow, h, (const bf16_t*)(ws + WS_SF) + ((size_t)chain * 128 + c) * 16384, o);
        h3_dir<1>(lds, zrow, h, (const bf16_t*)(ws + WS_SB) + ((size_t)chain * 128 + c) * 16384, o);
        float ssq[4];
#pragma unroll
        for (int i = 0; i < 4; ++i) { float s = 0.f;
#pragma unroll
            for (int nt = 0; nt < 8; ++nt) s += o[nt][i] * o[nt][i];
            s += __shfl_xor(s, 1); s += __shfl_xor(s, 2); s += __shfl_xor(s, 4); s += __shfl_xor(s, 8);
            ssq[i] = 1.0f / sqrtf(s * (1.0f / 128.0f) + LN_EPS); }
#pragma unroll
        for (int nt = 0; nt < 8; ++nt)
#pragma unroll
            for (int i = 0; i < 4; ++i) STGF[(4 * kq + i) * 132 + 16 * nt + r] = o[nt][i] * ssq[i];
        WAVE_LDS_FENCE();
#pragma unroll
        for (int it = 0; it < 4; ++it) {
            const int p = lane + 64 * it, row = p >> 4, c8 = p & 15;
            const f32x4 a = *(const f32x4*)(STGF + row * 132 + c8 * 8), bq = *(const f32x4*)(STGF + row * 132 + c8 * 8 + 4);
            const f32x4 g0 = *(const f32x4*)(norm_g + c8 * 8), g1 = *(const f32x4*)(norm_g + c8 * 8 + 4);
            bf16_t* zr = Z + (tok0 + row) * HIN + h * 128 + c8 * 8;
            const u32x4 gw = *(const u32x4*)(zr + 4096);
            const f32x4 t0 = {bf_lo(gw.x), bf_hi(gw.x), bf_lo(gw.y), bf_hi(gw.y)}, t1 = {bf_lo(gw.z), bf_hi(gw.z), bf_lo(gw.w), bf_hi(gw.w)};
            *(u32x4*)zr = pack8(a * g0 * t0, bq * g1 * t1);
        }
        __syncthreads();
    }
}

#define LAS __attribute__((address_space(3)))
#define XB_TMO      128
#define XB_XCNT(j)  (256  + 64 * (j))
#define XB_XSUB(j)  (1280 + 64 * (j))
#define XB_XGEN(j)  (2304 + 64 * (j))
#define XB_TOP      3328
#define XB_TOPGEN   3392
#define XCD_BAR_WORDS 3456
#define XB_SPIN_CAP (1u << 18)

__device__ __forceinline__ unsigned xb_ld(unsigned* p)              { return __hip_atomic_load(p, __ATOMIC_RELAXED, __HIP_MEMORY_SCOPE_AGENT); }
__device__ __forceinline__ unsigned xb_add(unsigned* p, unsigned v) { return __hip_atomic_fetch_add(p, v, __ATOMIC_RELAXED, __HIP_MEMORY_SCOPE_AGENT); }
__device__ __forceinline__ unsigned xb_xcc_id() { return (unsigned)__builtin_amdgcn_s_getreg((3 << 11) | 20) & 0xFu; }
#define XB_SPIN(cond, bar) do { unsigned _sp = 0; while (cond) { __builtin_amdgcn_s_sleep(1); \
    if ((++_sp & 255u) == 0u) { if (xb_ld(&(bar)[XB_TMO])) break; if (_sp > XB_SPIN_CAP) { atomicAdd(&(bar)[XB_TMO], 1u); break; } } } } while (0)

struct XcdBarrier {
    unsigned* bar; unsigned x;
    volatile LAS unsigned* st;
};

__device__ __forceinline__ XcdBarrier xcd_barrier_post(unsigned* bar, volatile LAS unsigned* st) {
    XcdBarrier b; b.bar = bar; b.x = xb_xcc_id(); b.st = st;
    if (threadIdx.x == 0) (void)xb_add(&bar[XB_XCNT(b.x)], 1u);
    return b;
}
__device__ __forceinline__ void xcd_barrier_complete(unsigned* bar, unsigned x, unsigned& nloc, unsigned& nx) {
    const unsigned G = gridDim.x * gridDim.y * gridDim.z;
    unsigned sum, cnt, mine, sp = 0u;
    for (;;) {
        sum = 0u; cnt = 0u; mine = 0u;
#pragma unroll
        for (unsigned j = 0; j < 16; ++j) { const unsigned c = xb_ld(&bar[XB_XCNT(j)]); sum += c; cnt += (c > 0u) ? 1u : 0u; mine = (j == x) ? c : mine; }
        if (sum == G) break;
        __builtin_amdgcn_s_sleep(1);
        if ((++sp & 255u) == 0u) { if (xb_ld(&bar[XB_TMO])) break; if (sp > XB_SPIN_CAP) { atomicAdd(&bar[XB_TMO], 1u); break; } }
    }
    nloc = mine > 0u ? mine : 1u; nx = cnt > 0u ? cnt : 1u;
}

__device__ __forceinline__ void xcd_barrier(const XcdBarrier& b) {
    asm volatile("s_waitcnt vmcnt(0)" ::: "memory");
    __syncthreads();
    if (threadIdx.x == 0) {
        unsigned* bar = b.bar;
        __builtin_amdgcn_s_waitcnt(0);
        unsigned nloc = b.st[0], nx = b.st[1];
        if (nloc == 0u) { xcd_barrier_complete(bar, b.x, nloc, nx); b.st[0] = nloc; b.st[1] = nx; }
        const unsigned old = xb_add(&bar[XB_XSUB(b.x)], 1u);
        const unsigned gen = old / nloc;
        if (old + 1u == (gen + 1u) * nloc) {
            __builtin_amdgcn_fence(__ATOMIC_RELEASE, "agent");
            asm volatile("s_waitcnt vmcnt(0)" ::: "memory");
            const unsigned og = xb_add(&bar[XB_TOP], 1u);
            const unsigned tg = og / nx;
            if (og + 1u == (tg + 1u) * nx) xb_add(&bar[XB_TOPGEN], 1u);
            else XB_SPIN(xb_ld(&bar[XB_TOPGEN]) == tg, bar);
            __builtin_amdgcn_fence(__ATOMIC_ACQUIRE, "agent");
            xb_add(&bar[XB_XGEN(b.x)], 1u);
            asm volatile("s_waitcnt vmcnt(0)" ::: "memory");
        } else {
            XB_SPIN(xb_ld(&bar[XB_XGEN(b.x)]) == gen, bar);
            __builtin_amdgcn_fence(__ATOMIC_ACQUIRE, "agent");
            asm volatile("s_waitcnt vmcnt(0)" ::: "memory");
        }
    }
    __syncthreads();
}

#define GEMM_PHASE(EPI, Aptr, LDA, Bptr, LDB, NN, KK, Eobj) do { pg8::Gemm g_{(const bf16_t*)(Aptr), (const bf16_t*)(Bptr), M, (NN), (KK), (LDA), (LDB)}; pg8::StaticOrder S_; S_.init(M, (NN), G, blk); \
    pg8::gemm_phase<EPI, pg8::StaticOrder, true, true>((PG8_LAS unsigned char*)lds, g_, S_, (Eobj)); } while (0)

#define GSYNC() do { for (int r_ = 0; r_ < REP_SYNC; ++r_) xcd_barrier(bar); } while (0)
#define KPTR() KP kp = (KP)__builtin_amdgcn_kernarg_segment_ptr(); int G = gridDim.x, blk = blockIdx.x; asm volatile("" : "+s"(kp), "+s"(G), "+s"(blk)); unsigned char* ws = kp->ws; (void)ws
template <int L> __device__ __forceinline__ void layer_fwd(unsigned char* lds, const XcdBarrier& bar) {
        constexpr int j = L >> 1; constexpr bool att = (L & 1) == 0;
        for (int r_ = 0; r_ < REP_WCONV; ++r_) { KPTR(); wconv_phase(kp, L, lds, G, blk); }
        GSYNC();
        if (att) {
            { KPTR(); EpiQKV E{(bf16_t*)(ws + WS_Q), (bf16_t*)(ws + WS_K), (bf16_t*)(ws + WS_V), (const float*)(ws + WS_ROPE)}; GEMM_PHASE(EpiQKV, ws + WS_XBX, D, ws + WS_WIN, D, NQKV, D, E); }
            GSYNC();
            for (int r_ = 0; r_ < REP_ATT; ++r_) { KPTR(); attn_phase(lds, (const bf16_t*)(ws + WS_Q), (const bf16_t*)(ws + WS_K), (const bf16_t*)(ws + WS_V), (bf16_t*)(ws + WS_O), kp->att_sink + j * 16, G, blk); }
            GSYNC();
            { KPTR(); EpiRes<false> E{L == 0 ? kp->x : kp->out, kp->out, (bf16_t*)(ws + WS_XBX), (f32x2*)(ws + WS_ST1), nullptr, nullptr, nullptr}; GEMM_PHASE(EpiRes<false>, ws + WS_O, D, ws + WS_WOUT, D, D, D, E); }
            GSYNC();
        } else {
            { KPTR(); EpiHin E{(bf16_t*)(ws + WS_Z), (const float*)(ws + WS_LB)}; GEMM_PHASE(EpiHin, ws + WS_XBX, D, ws + WS_WIN, D, HIN, D, E); }
            GSYNC();
            for (int r_ = 0; r_ < REP_H1; ++r_) { KPTR(); h1_phase(lds, ws, G, blk); }
            GSYNC();
            { KPTR(); h2_phase(ws, G, blk); }
            GSYNC();
            { KPTR(); h3_phase(lds, ws, kp->hg_ng + j * 128, G, blk); }
            GSYNC();
            { KPTR(); EpiRes<false> E{kp->out, kp->out, (bf16_t*)(ws + WS_XBX), (f32x2*)(ws + WS_ST1), nullptr, nullptr, nullptr}; GEMM_PHASE(EpiRes<false>, ws + WS_Z, HIN, ws + WS_WOUT, D, D, D, E); }
            GSYNC();
        }
        { KPTR(); float* vec = (float*)(ws + WS_VEC); EpiFfn1 E{(bf16_t*)(ws + WS_H), (const f32x2*)(ws + WS_ST1), vec, vec + 5632}; GEMM_PHASE(EpiFfn1, ws + WS_XBX, D, ws + WS_W1, D, 2 * DFF, D, E); }
        { KPTR(); EpiPlain E{(bf16_t*)(ws + WS_PP), D}; GEMM_PHASE(EpiPlain, ws + WS_PB, PLE, ws + WS_WP, PLE, D, PLE, E); }
        GSYNC();
        { KPTR(); EpiRes<true> E{kp->out, kp->out, (bf16_t*)(ws + WS_XBY), (f32x2*)(ws + WS_ST2), (const f32x2*)(ws + WS_ST1), kp->lnm_g + L * D, kp->lnm_b + L * D}; GEMM_PHASE(EpiRes<true>, ws + WS_H, DFF, ws + WS_W2, DFF, D, DFF, E); }
        GSYNC();
        { KPTR(); float* vec = (float*)(ws + WS_VEC); EpiPle E{kp->out, (bf16_t*)(ws + WS_XBX), (const f32x2*)(ws + WS_ST2), kp->lnf_g + L * D, kp->lnf_b + L * D, vec + 11264, vec + 12288, (const bf16_t*)(ws + WS_PP)}; GEMM_PHASE(EpiPle, ws + WS_XBY, D, ws + WS_WG, D, D, D, E); }
        GSYNC();
}
__global__ void __launch_bounds__(512, 2) mk_fwd(Ptrs Parg) {
    extern __shared__ __attribute__((aligned(16))) unsigned char lds[];
    cg::grid_group grid = cg::this_grid();
    volatile LAS unsigned* bst = (volatile LAS unsigned*)((LAS unsigned char*)lds + (LDS_BYTES - 16));
    if (threadIdx.x < 4) bst[threadIdx.x] = 0u;
    __syncthreads();
    XcdBarrier bar = xcd_barrier_post((unsigned*)(Parg.ws + WS_CTL), bst);
    grid.sync();
    layer_fwd<0>(lds, bar); layer_fwd<1>(lds, bar); layer_fwd<2>(lds, bar); layer_fwd<3>(lds, bar);
}

extern "C" void kernel_launch(void* const* d_in, const int* in_sizes, int n_in, void* d_out, int out_size, void* d_ws, size_t ws_size, hipStream_t stream) {
    static int grid = 0;
    if (grid == 0) {
        if (n_in != 17 || out_size != M * D || ws_size < WS_END) { fprintf(stderr, "kernel_launch: unexpected problem: n_in %d out %d ws %zu (need %zu)\n", n_in, out_size, ws_size, (size_t)WS_END); grid = -1; return; }
        int dev = 0, cus = 0, per_cu = 0;
        (void)hipGetDevice(&dev);
        (void)hipDeviceGetAttribute(&cus, hipDeviceAttributeMultiprocessorCount, dev);
        (void)hipFuncSetAttribute((const void*)mk_fwd, hipFuncAttributeMaxDynamicSharedMemorySize, LDS_BYTES);
        (void)hipOccupancyMaxActiveBlocksPerMultiprocessor(&per_cu, (const void*)mk_fwd, 512, LDS_BYTES);
        if (per_cu < 1) fprintf(stderr, "kernel_launch: occupancy query says %d blocks/CU\n", per_cu);
        (void)hipGetLastError();
        grid = cus;
    }
    if (grid < 0) return;
    (void)hipMemsetAsync((char*)d_ws + WS_CTL, 0, CTL_ZERO_BYTES, stream);
    Ptrs p{};
    p.x = (const float*)d_in[0]; p.p = (const float*)d_in[1]; p.att_wqkv = (const float*)d_in[2]; p.att_sink = (const float*)d_in[3]; p.att_wo = (const float*)d_in[4];
    p.hg_win = (const float*)d_in[5]; p.hg_lb = (const float*)d_in[6]; p.hg_ng = (const float*)d_in[7]; p.hg_wo = (const float*)d_in[8];
    p.lnm_g = (const float*)d_in[9]; p.lnm_b = (const float*)d_in[10]; p.ffn_win = (const float*)d_in[11]; p.ffn_wout = (const float*)d_in[12];
    p.lnf_g = (const float*)d_in[13]; p.lnf_b = (const float*)d_in[14]; p.ple_wg = (const float*)d_in[15]; p.ple_wp = (const float*)d_in[16];
    p.out = (float*)d_out; p.ws = (unsigned char*)d_ws;
    void* args[] = {&p};
    hipError_t e = hipLaunchCooperativeKernel((const void*)mk_fwd, dim3(grid), dim3(512), args, LDS_BYTES, stream);
    if (e != hipSuccess) fprintf(stderr, "kernel_launch: cooperative launch failed: %s (grid %d)\n", hipGetErrorString(e), grid);
}
```

```cpp
#include <hip/hip_runtime.h>
#include <hip/hip_cooperative_groups.h>
#include <cstdio>
#include <cstdint>
namespace cg = cooperative_groups;
namespace pg8 {
#define PG8_LAS __attribute__((address_space(3)))
typedef unsigned short bf16_t;
typedef short bf16x8 __attribute__((ext_vector_type(8)));
typedef float f32x4 __attribute__((ext_vector_type(4)));
typedef unsigned u32x4 __attribute__((ext_vector_type(4)));
constexpr int BM = 256, BK = 64, HALF = 128, HTB = HALF * BK * 2  , STAGE_BYTES = 8 * HTB, NXCD = 8, WGM = 8;

__host__ __device__ __forceinline__ int lds_byte(int r, int c) { const int st = (r >> 4) * 2 + (c >> 5), rr = r & 15, cc = c & 31, ob = rr * 64 + cc * 2; return st * 1024 + (ob ^ (((ob >> 9) & 1) << 5)); }
__host__ __device__ __forceinline__ void stage_rc(int b, int& R, int& C) { const int st = b / 1024, sb = b % 1024, swz = sb ^ (((sb >> 9) & 1) << 5); R = (st >> 1) * 16 + swz / 64; C = (st & 1) * 32 + (swz % 64) / 2; }
__host__ __device__ __forceinline__ int perm32(int rho) { const int n = rho >> 4, i = rho & 15; return 8 * (i >> 2) + 4 * n + (i & 3); }

struct Unit { int pm, pn; };
struct Gemm { const bf16_t* A; const bf16_t* Bt; int M, N, K, lda, ldb; size_t ahs; };

struct StaticOrder {
    int nM, nN, nwg, G, c;
    __host__ __device__ void init(int M, int N, int G_, int c_) { nM = M / BM; nN = N / BM; nwg = nM * nN; G = G_; c = c_; }
    __host__ __device__ bool next(int i, Unit& u) const {
        const long L = (long)i * G + c; if (L >= nwg) return false;
        int wgid = (int)L; { const int q = nwg / NXCD, r = nwg % NXCD, xcd = wgid % NXCD, off = wgid / NXCD; wgid = (xcd < r ? xcd * (q + 1) : r * (q + 1) + (xcd - r) * q) + off; }
        const int nig = WGM * nN, gid = wgid / nig, fm = gid * WGM, gsz = (nM - fm) < WGM ? (nM - fm) : WGM;
        u.pm = fm + ((wgid % nig) % gsz); u.pn = (wgid % nig) / gsz; return true;
    }
    __device__ __forceinline__ void a_ready(const Unit&) const {}
    __device__ __forceinline__ void done(const Unit&) const {}
};

__device__ __forceinline__ unsigned cvt_pk_bf16(float lo, float hi) { unsigned r; asm volatile("v_cvt_pk_bf16_f32 %0, %1, %2" : "=v"(r) : "v"(lo), "v"(hi)); return r; }
template <class Epi, class Sched, bool ALIGN_EPI = false, bool SP2 = false>
__device__ __forceinline__ void gemm_phase(PG8_LAS unsigned char* lds, const Gemm g, const Sched& S, const Epi& E) {
    int tid_l = threadIdx.x; asm volatile("" : "+v"(tid_l));
    const int tid = tid_l, wid = __builtin_amdgcn_readfirstlane(tid >> 6), lane = tid & 63, wr = wid >> 2, wc = wid & 3, fr = lane & 15, fq = lane >> 4;
    const int K = g.K, nt = K / BK;
    unsigned voffA[2], voffB[2];
#pragma unroll
    for (int i = 0; i < 2; ++i) { int R, C; stage_rc(tid * 16 + i * 8192, R, C); const int Rb = Epi::PERM ? ((R & ~31) + perm32(R & 31)) : R;
        voffA[i] = (unsigned)(R * g.lda + C) * 2u; voffB[i] = (unsigned)(Rb * g.ldb + C) * 2u; }
    const size_t kstep = (size_t)(BK * 2);
#define PG8_AK(t_) (g.ahs ? (size_t)((t_) >> 1) * g.ahs + (size_t)((t_) & 1) * 128 : (size_t)(t_) * kstep)
    const size_t hstepA = (size_t)HALF * g.lda * 2, hstepB = (size_t)HALF * g.ldb * 2;
    const size_t tstepA = 2 * hstepA, tstepB = 2 * hstepB;
    const unsigned ldsw = (unsigned)wid * 1024u;
    const int aoff = lds_byte(wr * 64 + fr, fq * 8), boff = lds_byte(wc * 32 + fr, fq * 8);
#define PG8_SA(b, h) (((b) * 2 + (h)) * HTB)
#define PG8_SB(b, h) ((4 + (b) * 2 + (h)) * HTB)
#define PG8_STAGE(bufoff, gbase, voff) do { _Pragma("unroll") for (int _i = 0; _i < 2; ++_i) \
        __builtin_amdgcn_global_load_lds((const unsigned*)((const char*)(gbase) + (voff)[_i]), (PG8_LAS unsigned*)(lds + (bufoff) + ldsw + _i * 8192), 16, 0, 0); } while (0)
#define PG8_LDA(dst, b, h) do { _Pragma("unroll") for (int m = 0; m < 4; ++m) _Pragma("unroll") for (int k = 0; k < 2; ++k) dst[m][k] = *(const PG8_LAS bf16x8*)(lds + PG8_SA(b, h) + aoff + m * 2048 + k * 1024); } while (0)
#define PG8_LDB(dst, b, h) do { _Pragma("unroll") for (int n = 0; n < 2; ++n) _Pragma("unroll") for (int k = 0; k < 2; ++k) dst[n][k] = *(const PG8_LAS bf16x8*)(lds + PG8_SB(b, h) + boff + n * 2048 + k * 1024); } while (0)
#define PG8_MMA(ai, bj, At, Bt) do { __builtin_amdgcn_s_setprio(1); _Pragma("unroll") for (int m = 0; m < 4; ++m) _Pragma("unroll") for (int n = 0; n < 2; ++n) _Pragma("unroll") for (int k = 0; k < 2; ++k) \
        acc[ai][bj][m][n] = __builtin_amdgcn_mfma_f32_16x16x32_bf16(Bt[n][k], At[m][k], acc[ai][bj][m][n], 0, 0, 0); __builtin_amdgcn_s_setprio(0); } while (0)
#define PG8_WAIT_V(n) asm volatile("s_waitcnt vmcnt(" #n ")" ::: "memory")
#define PG8_WAIT_L(n) asm volatile("s_waitcnt lgkmcnt(" #n ")" ::: "memory")
#define PG8_BAR __builtin_amdgcn_s_barrier()
#define PG8_SCHED __builtin_amdgcn_sched_barrier(0)
    Unit cur, nxt; int ui = 0;
    if (!S.next(0, cur)) return;
    f32x4 acc[2][2][4][2];
#pragma unroll
    for (int a = 0; a < 2; ++a)
#pragma unroll
        for (int b = 0; b < 2; ++b)
#pragma unroll
            for (int m = 0; m < 4; ++m)
#pragma unroll
                for (int n = 0; n < 2; ++n) acc[a][b][m][n] = (f32x4){0.f, 0.f, 0.f, 0.f};
    bf16x8 At[4][2], B0[2][2], B1[2][2];
    const char* cA = (const char*)g.A + (size_t)cur.pm * tstepA; const char* cB = (const char*)g.Bt + (size_t)cur.pn * tstepB;
    S.a_ready(cur);
    if constexpr (SP2) {
        PG8_STAGE(PG8_SB(0, 0), cB, voffB); PG8_STAGE(PG8_SB(0, 1), cB + hstepB, voffB); PG8_STAGE(PG8_SA(0, 0), cA, voffA); PG8_STAGE(PG8_SA(0, 1), cA + hstepA, voffA);
        if (wr == 1) PG8_BAR;
        PG8_WAIT_V(2); PG8_BAR;
        PG8_STAGE(PG8_SB(1, 0), cB + kstep, voffB); PG8_STAGE(PG8_SA(1, 0), cA + PG8_AK(1), voffA); PG8_STAGE(PG8_SB(1, 1), cB + hstepB + kstep, voffB);
        PG8_WAIT_V(6); PG8_BAR;
    } else {
        PG8_STAGE(PG8_SB(0, 0), cB, voffB); PG8_STAGE(PG8_SA(0, 0), cA, voffA); PG8_STAGE(PG8_SB(0, 1), cB + hstepB, voffB); PG8_STAGE(PG8_SA(0, 1), cA + hstepA, voffA);
        if (wr == 1) PG8_BAR;
        PG8_WAIT_V(4); PG8_BAR;
        PG8_STAGE(PG8_SB(1, 0), cB + kstep, voffB); PG8_STAGE(PG8_SA(1, 0), cA + PG8_AK(1), voffA); PG8_STAGE(PG8_SB(1, 1), cB + hstepB + kstep, voffB);
        PG8_WAIT_V(6); PG8_BAR;
    }
    for (;;) {
        const bool has_next = S.next(ui + 1, nxt);
        const char* nA = has_next ? (const char*)g.A + (size_t)nxt.pm * tstepA : cA; const char* nB = has_next ? (const char*)g.Bt + (size_t)nxt.pn * tstepB : cB;
        for (int t = 0; t < nt; t += 2) {
            const bool last = (t == nt - 2);
            const char* a1 = cA + PG8_AK(t + 1);
            const char* a2 = last ? nA : cA + PG8_AK(t + 2); const char* b2 = last ? nB : cB + (size_t)(t + 2) * kstep;
            const char* a3 = last ? nA + PG8_AK(1) : cA + PG8_AK(t + 3); const char* b3 = b2 + kstep;
            if (last && has_next) S.a_ready(nxt);
            if constexpr (SP2) {
            PG8_LDB(B0, 0, 0); PG8_LDB(B1, 0, 1); PG8_SCHED; PG8_LDA(At, 0, 0); PG8_STAGE(PG8_SA(1, 1), a1 + hstepA, voffA);
            PG8_WAIT_V(8); PG8_WAIT_L(0); PG8_BAR; PG8_MMA(0, 0, At, B0); PG8_MMA(0, 1, At, B1); PG8_BAR; PG8_SCHED;
            PG8_LDA(At, 0, 1); PG8_STAGE(PG8_SB(0, 0), b2, voffB); PG8_STAGE(PG8_SB(0, 1), b2 + hstepB, voffB); PG8_STAGE(PG8_SA(0, 0), a2, voffA);
            PG8_WAIT_V(8); PG8_WAIT_L(0); PG8_BAR; PG8_MMA(1, 0, At, B0); PG8_MMA(1, 1, At, B1); PG8_BAR; PG8_SCHED;
            PG8_LDB(B0, 1, 0); PG8_LDB(B1, 1, 1); PG8_SCHED; PG8_LDA(At, 1, 0); PG8_STAGE(PG8_SA(0, 1), a2 + hstepA, voffA);
            PG8_WAIT_V(8); PG8_WAIT_L(0); PG8_BAR; PG8_MMA(0, 0, At, B0); PG8_MMA(0, 1, At, B1); PG8_BAR; PG8_SCHED;
            PG8_LDA(At, 1, 1); PG8_STAGE(PG8_SB(1, 0), b3, voffB); PG8_STAGE(PG8_SB(1, 1), b3 + hstepB, voffB); PG8_STAGE(PG8_SA(1, 0), a3, voffA);
            PG8_WAIT_V(8); PG8_WAIT_L(0); PG8_BAR; PG8_MMA(1, 0, At, B0); PG8_MMA(1, 1, At, B1); PG8_BAR; PG8_SCHED;
            } else {
            PG8_LDB(B0, 0, 0); PG8_SCHED; PG8_LDA(At, 0, 0); PG8_STAGE(PG8_SA(1, 1), a1 + hstepA, voffA);
            PG8_WAIT_L(8); PG8_BAR; PG8_WAIT_L(0); PG8_MMA(0, 0, At, B0); PG8_BAR; PG8_SCHED;
            PG8_LDB(B1, 0, 1); PG8_STAGE(PG8_SB(0, 0), b2, voffB);
            PG8_BAR; PG8_WAIT_L(0); PG8_MMA(0, 1, At, B1); PG8_BAR;
            PG8_LDA(At, 0, 1); PG8_STAGE(PG8_SA(0, 0), a2, voffA);
            PG8_BAR; PG8_WAIT_L(0); PG8_MMA(1, 0, At, B0); PG8_BAR; PG8_SCHED;
            PG8_STAGE(PG8_SB(0, 1), b2 + hstepB, voffB);
            PG8_WAIT_V(6); PG8_BAR; PG8_MMA(1, 1, At, B1); PG8_BAR;
            PG8_LDB(B0, 1, 0); PG8_SCHED; PG8_LDA(At, 1, 0); PG8_STAGE(PG8_SA(0, 1), a2 + hstepA, voffA);
            PG8_WAIT_L(8); PG8_BAR; PG8_WAIT_L(0); PG8_MMA(0, 0, At, B0); PG8_BAR; PG8_SCHED;
            PG8_LDB(B1, 1, 1); PG8_STAGE(PG8_SB(1, 0), b3, voffB);
            PG8_BAR; PG8_WAIT_L(0); PG8_MMA(0, 1, At, B1); PG8_BAR;
            PG8_LDA(At, 1, 1); PG8_STAGE(PG8_SA(1, 0), a3, voffA);
            PG8_BAR; PG8_WAIT_L(0); PG8_MMA(1, 0, At, B0); PG8_BAR; PG8_SCHED;
            PG8_STAGE(PG8_SB(1, 1), b3 + hstepB, voffB);
            PG8_WAIT_V(6); PG8_BAR; PG8_MMA(1, 1, At, B1); PG8_BAR;
            }
        }
        if constexpr (ALIGN_EPI) { if (wr == 0) PG8_BAR; }
        if constexpr (!Epi::AFTER_DRAIN) { E(acc, cur, wr, wc, fr, fq); S.done(cur); }
        if (!has_next) break;
#pragma unroll
        for (int a = 0; a < 2; ++a)
#pragma unroll
            for (int b = 0; b < 2; ++b)
#pragma unroll
                for (int m = 0; m < 4; ++m)
#pragma unroll
                    for (int n = 0; n < 2; ++n) acc[a][b][m][n] = (f32x4){0.f, 0.f, 0.f, 0.f};
        cur = nxt; cA = nA; cB = nB; ++ui;
        if constexpr (ALIGN_EPI) { if (wr == 1) PG8_BAR; }
    }
    PG8_WAIT_V(0);
    if constexpr (!ALIGN_EPI) { if (wr == 0) PG8_BAR; }
    PG8_BAR;
    if constexpr (Epi::AFTER_DRAIN) { E.fused(acc, cur, wr, wc, fr, fq, lds, wid, lane); S.done(cur); }
#undef PG8_SA
#undef PG8_SB
#undef PG8_STAGE
#undef PG8_LDA
#undef PG8_LDB
#undef PG8_MMA
#undef PG8_WAIT_V
#undef PG8_WAIT_L
#undef PG8_BAR
#undef PG8_SCHED
}
}

using pg8::bf16_t; using pg8::bf16x8; using pg8::f32x4; using pg8::u32x4; using pg8::Unit; using pg8::cvt_pk_bf16;
typedef unsigned u32x2 __attribute__((ext_vector_type(2)));
typedef float f32x2 __attribute__((ext_vector_type(2)));
typedef float f32x16 __attribute__((ext_vector_type(16)));

constexpr int BATCH = 2, SEQ = 16384, D = 1024, M = BATCH * SEQ, DFF = 2816, PLE = 256, DEPTH = 4;
constexpr int NQKV = 1536, HIN = 5120;
constexpr float ALPHA = 1.681792830507429f, LN_EPS = 1e-5f, LOG2E = 1.4426950408889634f;
constexpr size_t MiB = (size_t)1 << 20;
constexpr size_t WS_WIN = 0, WS_WOUT = 10 * MiB, WS_W1 = 12 * MiB, WS_W2 = 23 * MiB, WS_WG = 29 * MiB, WS_WP = 31 * MiB, WS_VEC = 31 * MiB + 512 * 1024;
constexpr size_t WS_ST1 = 32 * MiB, WS_ST2 = 36 * MiB, WS_XBX = 40 * MiB, WS_XBY = 104 * MiB, WS_PP = 168 * MiB;
constexpr size_t WS_Q = 248 * MiB, WS_K = 312 * MiB, WS_V = 328 * MiB, WS_O = 344 * MiB, WS_H = 248 * MiB;
constexpr size_t WS_Z = 104 * MiB, WS_SB = 424 * MiB,     WS_PB = 488 * MiB, WS_ROPE = 504 * MiB, WS_LB = 505 * MiB, WS_DEC = 506 * MiB, WS_CTL = 508 * MiB, WS_VECP = 509 * MiB, WS_END = 510 * MiB;
constexpr size_t CTL_ZERO_BYTES = 16384;
constexpr int LDS_BYTES = 147456;
#define X1(...) __VA_ARGS__
#define X2(...) __VA_ARGS__ __VA_ARGS__
#define REP_SYNC X1
#define REP_WCONV X1
#define REP_ATT X1
#define REP_H1 X1
#define X0(...)
#define REP_H3 X0
#define REP_F1 X1
#define REP_HIN X1

__device__ __forceinline__ float bf_lo(unsigned w) { return __uint_as_float(w << 16); }
__device__ __forceinline__ float bf_hi(unsigned w) { return __uint_as_float(w & 0xffff0000u); }
typedef float f32x2_cv __attribute__((ext_vector_type(2))); typedef __bf16 bf16x2_cv __attribute__((ext_vector_type(2)));
__device__ __forceinline__ unsigned cvt_pk_c(float lo, float hi) { const f32x2_cv v = {lo, hi}; const bf16x2_cv b = __builtin_convertvector(v, bf16x2_cv); return __builtin_bit_cast(unsigned, b); }
__device__ __forceinline__ unsigned f2bf(float f) { unsigned u = __float_as_uint(f); return (u + 0x7fffu + ((u >> 16) & 1u)) >> 16; }
__device__ __forceinline__ float sigmoidf_(float x) { return __builtin_amdgcn_rcpf(1.0f + __expf(-x)); }
__device__ __forceinline__ u32x4 pack8(const f32x4 a, const f32x4 b) { u32x4 w; w.x = cvt_pk_bf16(a[0], a[1]); w.y = cvt_pk_bf16(a[2], a[3]); w.z = cvt_pk_bf16(b[0], b[1]); w.w = cvt_pk_bf16(b[2], b[3]); return w; }

__device__ __forceinline__ void load_row_stats(const f32x2* part, int pm, int wr, int fr, int fq, float (&mu)[8], float (&rs)[8]) {
    float mye[2], rse[2];
#pragma unroll
    for (int e = 0; e < 2; ++e) {
        const int row = pm * 256 + (fq >> 1) * 128 + wr * 64 + (2 * (fq & 1) + e) * 16 + fr;
        const f32x4* p = (const f32x4*)(part + (size_t)row * 16);
        float s = 0.f, q = 0.f;
#pragma unroll
        for (int i = 0; i < 8; ++i) { const f32x4 v = p[i]; s += v[0] + v[2]; q += v[1] + v[3]; }
        const float mean = s * (1.0f / 1024.0f); float var = q * (1.0f / 1024.0f) - mean * mean; var = var > 0.f ? var : 0.f;
        mye[e] = mean; rse[e] = __builtin_amdgcn_rsqf(var + LN_EPS);
    }
#pragma unroll
    for (int ai = 0; ai < 2; ++ai)
#pragma unroll
        for (int m = 0; m < 4; ++m) { const int src = fr + 16 * (ai * 2 + (m >> 1)); mu[ai * 4 + m] = __shfl(mye[m & 1], src); rs[ai * 4 + m] = __shfl(rse[m & 1], src); }
}

__device__ __forceinline__ void load_row_stats2(const f32x2* part, int pm, int wr, int fr, int fq, float (&mye)[2], float (&rse)[2]) {
#pragma unroll
    for (int e = 0; e < 2; ++e) {
        const int row = pm * 256 + (fq >> 1) * 128 + wr * 64 + (2 * (fq & 1) + e) * 16 + fr;
        const f32x4* p = (const f32x4*)(part + (size_t)row * 16);
        float s = 0.f, q = 0.f;
#pragma unroll
        for (int i = 0; i < 8; ++i) { const f32x4 v = p[i]; s += v[0] + v[2]; q += v[1] + v[3]; }
        const float mean = s * (1.0f / 1024.0f); float var = q * (1.0f / 1024.0f) - mean * mean; var = var > 0.f ? var : 0.f;
        mye[e] = mean; rse[e] = __builtin_amdgcn_rsqf(var + LN_EPS);
    }
}
#define ROW_MU(ai, m) __shfl(mye[(m) & 1], fr + 16 * ((ai) * 2 + ((m) >> 1)))
#define ROW_RS(ai, m) __shfl(rse[(m) & 1], fr + 16 * ((ai) * 2 + ((m) >> 1)))

struct EpiPlain {
    static constexpr bool PERM = true, AFTER_DRAIN = false;
    bf16_t* O; int ldc;
    __device__ __forceinline__ void operator()(const f32x4 (&acc)[2][2][4][2], const Unit& u, int wr, int wc, int fr, int fq) const {
        const int row0 = u.pm * 256 + wr * 64 + fr, col0 = u.pn * 256 + wc * 32 + 8 * fq;
#pragma unroll
        for (int ai = 0; ai < 2; ++ai)
#pragma unroll
            for (int m = 0; m < 4; ++m) { bf16_t* rowp = O + (size_t)(row0 + ai * 128 + m * 16) * ldc + col0;
#pragma unroll
                for (int bj = 0; bj < 2; ++bj) *(u32x4*)(rowp + bj * 128) = pack8(acc[ai][bj][m][0], acc[ai][bj][m][1]); }
    }
};

struct EpiQKV {
    static constexpr bool PERM = true, AFTER_DRAIN = false;
    bf16_t *Q, *K, *V; const float* rope;
    __device__ __forceinline__ void operator()(const f32x4 (&acc)[2][2][4][2], const Unit& u, int wr, int wc, int fr, int fq) const {
        bf16_t* base; int ldc, colt; float sc;
        if (u.pn < 4) { base = Q; ldc = 1024; colt = u.pn * 256; sc = 0.125f * LOG2E; } else if (u.pn == 4) { base = K; ldc = 256; colt = 0; sc = 1.f; } else { base = V; ldc = 256; colt = 0; sc = 1.f; }
        const bool do_rope = (u.pn < 5) && ((wc & 1) == 0) && (fq < 2);
        const int col0 = colt + wc * 32 + 8 * fq;
#pragma unroll
        for (int ai = 0; ai < 2; ++ai)
#pragma unroll
            for (int m = 0; m < 4; ++m) {
                const int row = u.pm * 256 + ai * 128 + wr * 64 + m * 16 + fr, pos = row & (SEQ - 1);
                f32x4 c4 = {1.f, 1.f, 1.f, 1.f}, s4 = {0.f, 0.f, 0.f, 0.f};
                if (do_rope) { c4 = *(const f32x4*)(rope + (size_t)pos * 8 + 4 * fq); s4 = *(const f32x4*)(rope + (size_t)SEQ * 8 + (size_t)pos * 8 + 4 * fq); }
#pragma unroll
                for (int bj = 0; bj < 2; ++bj) {
                    f32x4 v0 = acc[ai][bj][m][0], v1 = acc[ai][bj][m][1];
                    if (do_rope) {
                        f32x4 r0, r1;
                        r0[0] = v0[0] * c4[0] - v0[1] * s4[0]; r0[1] = v0[1] * c4[0] + v0[0] * s4[0];
                        r0[2] = v0[2] * c4[1] - v0[3] * s4[1]; r0[3] = v0[3] * c4[1] + v0[2] * s4[1];
                        r1[0] = v1[0] * c4[2] - v1[1] * s4[2]; r1[1] = v1[1] * c4[2] + v1[0] * s4[2];
                        r1[2] = v1[2] * c4[3] - v1[3] * s4[3]; r1[3] = v1[3] * c4[3] + v1[2] * s4[3];
                        v0 = r0; v1 = r1;
                    }
                    v0 = v0 * sc; v1 = v1 * sc;
                    *(u32x4*)(base + (size_t)row * ldc + col0 + bj * 128) = pack8(v0, v1);
                }
            }
    }
};

struct EpiHin {
    static constexpr bool PERM = true, AFTER_DRAIN = false;
    bf16_t* Z; const float* lb;
    __device__ __forceinline__ void operator()(const f32x4 (&acc)[2][2][4][2], const Unit& u, int wr, int wc, int fr, int fq) const {
        const int seg = u.pn >> 2, col0 = u.pn * 256 + wc * 32 + 8 * fq;
#pragma unroll
        for (int bj = 0; bj < 2; ++bj) {
            f32x4 l0 = {0.f, 0.f, 0.f, 0.f}, l1 = l0;
            if (seg == 1 || seg == 2) { const float* lp = lb + (col0 + bj * 128 - 1024); l0 = *(const f32x4*)lp; l1 = *(const f32x4*)(lp + 4); }
#pragma unroll
            for (int ai = 0; ai < 2; ++ai)
#pragma unroll
                for (int m = 0; m < 4; ++m) {
                    const int row = u.pm * 256 + ai * 128 + wr * 64 + m * 16 + fr;
                    f32x4 v0 = acc[ai][bj][m][0], v1 = acc[ai][bj][m][1];
                    if (seg == 0 || seg == 4) {
#pragma unroll
                        for (int i = 0; i < 4; ++i) { v0[i] = v0[i] * sigmoidf_(v0[i]); v1[i] = v1[i] * sigmoidf_(v1[i]); }
                    } else if (seg == 1 || seg == 2) {
#pragma unroll
                        for (int i = 0; i < 4; ++i) { v0[i] = __builtin_amdgcn_logf(l0[i] + (1.f - l0[i]) * sigmoidf_(v0[i])); v1[i] = __builtin_amdgcn_logf(l1[i] + (1.f - l1[i]) * sigmoidf_(v1[i]));     }
                    }
                    *(u32x4*)(Z + ((size_t)(seg * 8 + 2 * (u.pn & 3) + bj) * M + row) * 128 + wc * 32 + 8 * fq) = pack8(v0, v1);
                }
        }
    }
};

__device__ __forceinline__ void split_hilo(const f32x4 y0, const f32x4 y1, u32x4& hi, u32x4& lo) {
    hi = pack8(y0, y1);
    const f32x4 h0 = {bf_lo(hi.x), bf_hi(hi.x), bf_lo(hi.y), bf_hi(hi.y)}, h1 = {bf_lo(hi.z), bf_hi(hi.z), bf_lo(hi.w), bf_hi(hi.w)};
    lo = pack8(y0 - h0, y1 - h1);
}
__device__ __forceinline__ void join_hilo(const u32x4 hi, const u32x4 lo, f32x4& y0, f32x4& y1) {
    y0 = (f32x4){bf_lo(hi.x) + bf_lo(lo.x), bf_hi(hi.x) + bf_hi(lo.x), bf_lo(hi.y) + bf_lo(lo.y), bf_hi(hi.y) + bf_hi(lo.y)};
    y1 = (f32x4){bf_lo(hi.z) + bf_lo(lo.z), bf_hi(hi.z) + bf_hi(lo.z), bf_lo(hi.w) + bf_lo(lo.w), bf_hi(hi.w) + bf_hi(lo.w)};
}
template <bool LNRES, bool F32IN> struct EpiRes {
    static constexpr bool PERM = true, AFTER_DRAIN = false;
    const float* resid; const bf16_t* rhi; const bf16_t* rlo; bf16_t* xb; bf16_t* wlo; f32x2* part_out; const f32x2* part_in; const float* g; const float* b;
    __device__ __forceinline__ void operator()(const f32x4 (&acc)[2][2][4][2], const Unit& u, int wr, int wc, int fr, int fq) const {
        float mye[2] = {0.f, 0.f}, rse[2] = {0.f, 0.f};
        if (LNRES) load_row_stats2(part_in, u.pm, wr, fr, fq, mye, rse);
        const int col0 = u.pn * 256 + wc * 32 + 8 * fq;
        const size_t tile_off = (size_t)(u.pm * 256 + wr * 64) * D + u.pn * 256 + wc * 32;
        const unsigned lane_off = (unsigned)fr * D + 8 * fq;
        float ss[8], qq[8];
#pragma unroll
        for (int i = 0; i < 8; ++i) { ss[i] = 0.f; qq[i] = 0.f; }
        constexpr int NB = LNRES ? 2 : 4;
#pragma unroll
        for (int bj = 0; bj < 2; ++bj) {
            f32x4 g0, g1, b0, b1;
            if (LNRES) { g0 = *(const f32x4*)(g + col0 + bj * 128); g1 = *(const f32x4*)(g + col0 + bj * 128 + 4); b0 = *(const f32x4*)(b + col0 + bj * 128); b1 = *(const f32x4*)(b + col0 + bj * 128 + 4); }
#pragma unroll
            for (int h0 = 0; h0 < 8; h0 += NB) {
                u32x4 rv[NB][2];
#pragma unroll
                for (int k = 0; k < NB; ++k) { const int idx = h0 + k, ai = idx >> 2, m = idx & 3; const unsigned off = lane_off + (unsigned)((ai * 128 + m * 16) * D + bj * 128);
                    if (F32IN) { rv[k][0] = *(const u32x4*)(resid + tile_off + off); rv[k][1] = *(const u32x4*)(resid + tile_off + off + 4); }
                    else { rv[k][0] = *(const u32x4*)(rhi + tile_off + off); rv[k][1] = *(const u32x4*)(rlo + tile_off + off); } }
#pragma unroll
                for (int k = 0; k < NB; ++k) { const int idx = h0 + k, ai = idx >> 2, m = idx & 3; const unsigned off = lane_off + (unsigned)((ai * 128 + m * 16) * D + bj * 128);
                    f32x4 r0, r1;
                    if (F32IN) { r0 = __builtin_bit_cast(f32x4, rv[k][0]); r1 = __builtin_bit_cast(f32x4, rv[k][1]); } else join_hilo(rv[k][0], rv[k][1], r0, r1);
                    if (LNRES) { const float mm = ROW_MU(ai, m), rr = ROW_RS(ai, m); r0 = (r0 - mm) * rr * g0 + b0; r1 = (r1 - mm) * rr * g1 + b1; }
                    const f32x4 y0 = r0 * ALPHA + acc[ai][bj][m][0], y1 = r1 * ALPHA + acc[ai][bj][m][1];
                    u32x4 hi, lo; split_hilo(y0, y1, hi, lo);
                    *(u32x4*)(xb + tile_off + off) = hi; *(u32x4*)(wlo + tile_off + off) = lo;
                    ss[idx] += (y0[0] + y0[1]) + (y0[2] + y0[3]) + (y1[0] + y1[1]) + (y1[2] + y1[3]);
                    qq[idx] += (y0[0] * y0[0] + y0[1] * y0[1]) + (y0[2] * y0[2] + y0[3] * y0[3]) + (y1[0] * y1[0] + y1[1] * y1[1]) + (y1[2] * y1[2] + y1[3] * y1[3]);
                }
            }
        }
#pragma unroll
        for (int ai = 0; ai < 2; ++ai)
#pragma unroll
            for (int m = 0; m < 4; ++m) {
                float s = ss[ai * 4 + m], q = qq[ai * 4 + m];
                s += __shfl_xor(s, 16); s += __shfl_xor(s, 32); q += __shfl_xor(q, 16); q += __shfl_xor(q, 32);
                const int row = u.pm * 256 + ai * 128 + wr * 64 + m * 16 + fr;
                if (fq == 0) part_out[(size_t)row * 16 + u.pn * 4 + wc] = (f32x2){s, q};
            }
    }
};

struct EpiFfn1 {
    static constexpr bool PERM = true, AFTER_DRAIN = false;
    bf16_t* H; const f32x2* part; const float* cs; const float* bw;
    __device__ __forceinline__ void operator()(const f32x4 (&acc)[2][2][4][2], const Unit& u, int wr, int wc, int fr, int fq) const {
        float mu[8], rs[8];
        load_row_stats(part, u.pm, wr, fr, fq, mu, rs);
        const int col0 = u.pn * 256 + wc * 32 + 8 * fq, hcol0 = u.pn * 128 + wc * 16 + 4 * fq;
#pragma unroll
        for (int bj = 0; bj < 2; ++bj) {
            const f32x4 c0 = *(const f32x4*)(cs + col0 + bj * 128), c1 = *(const f32x4*)(cs + col0 + bj * 128 + 4), w0 = *(const f32x4*)(bw + col0 + bj * 128), w1 = *(const f32x4*)(bw + col0 + bj * 128 + 4);
#pragma unroll
            for (int ai = 0; ai < 2; ++ai)
#pragma unroll
                for (int m = 0; m < 4; ++m) {
                    const int row = u.pm * 256 + ai * 128 + wr * 64 + m * 16 + fr; const float mm = mu[ai * 4 + m], rr = rs[ai * 4 + m];
                    const f32x4 v0 = (acc[ai][bj][m][0] - c0 * mm) * rr + w0, v1 = (acc[ai][bj][m][1] - c1 * mm) * rr + w1;
                    const float h0 = v0[0] * sigmoidf_(v0[0]) * v0[1], h1 = v0[2] * sigmoidf_(v0[2]) * v0[3], h2 = v1[0] * sigmoidf_(v1[0]) * v1[1], h3 = v1[2] * sigmoidf_(v1[2]) * v1[3];
                    u32x2 w; w.x = cvt_pk_bf16(h0, h1); w.y = cvt_pk_bf16(h2, h3);
                    *(u32x2*)(H + (size_t)row * DFF + hcol0 + bj * 64) = w;
                }
        }
    }
};

template <bool LAST> struct EpiPle {
    static constexpr bool PERM = true, AFTER_DRAIN = false;
    float* out; const bf16_t* yhi; const bf16_t* ylo; bf16_t* xb; bf16_t* wlo; const f32x2* part; const float *g, *b, *cs, *bw; const bf16_t* pp;
    __device__ __forceinline__ void operator()(const f32x4 (&acc)[2][2][4][2], const Unit& u, int wr, int wc, int fr, int fq) const {
        float mye[2], rse[2];
        load_row_stats2(part, u.pm, wr, fr, fq, mye, rse);
        const int col0 = u.pn * 256 + wc * 32 + 8 * fq;
        const size_t tile_off = (size_t)(u.pm * 256 + wr * 64) * D + u.pn * 256 + wc * 32;
        const unsigned lane_off = (unsigned)fr * D + 8 * fq;
#pragma unroll
        for (int bj = 0; bj < 2; ++bj) {
            const int cc = col0 + bj * 128;
            const f32x4 g0 = *(const f32x4*)(g + cc), g1 = *(const f32x4*)(g + cc + 4), b0 = *(const f32x4*)(b + cc), b1 = *(const f32x4*)(b + cc + 4);
            const f32x4 c0 = *(const f32x4*)(cs + cc), c1 = *(const f32x4*)(cs + cc + 4), w0 = *(const f32x4*)(bw + cc), w1 = *(const f32x4*)(bw + cc + 4);
#pragma unroll
            for (int am = 0; am < 8; am += 2) { const int ai = am >> 2;
                u32x4 yv[4][2]; u32x4 pv[4];
#pragma unroll
                for (int m = (am & 3); m < (am & 3) + 2; ++m) { const unsigned off = lane_off + (unsigned)((ai * 128 + m * 16) * D + bj * 128);
                    yv[m][0] = *(const u32x4*)(yhi + tile_off + off); yv[m][1] = *(const u32x4*)(ylo + tile_off + off); pv[m] = *(const u32x4*)(pp + tile_off + off); }
#pragma unroll
                for (int m = (am & 3); m < (am & 3) + 2; ++m) {
                    const unsigned off = lane_off + (unsigned)((ai * 128 + m * 16) * D + bj * 128); const float mm = ROW_MU(ai, m), rr = ROW_RS(ai, m);
                    f32x4 y0, y1; join_hilo(yv[m][0], yv[m][1], y0, y1); const u32x4 pw = pv[m];
                    const f32x4 p0 = {bf_lo(pw.x), bf_hi(pw.x), bf_lo(pw.y), bf_hi(pw.y)}, p1 = {bf_lo(pw.z), bf_hi(pw.z), bf_lo(pw.w), bf_hi(pw.w)};
                    f32x4 t0 = (acc[ai][bj][m][0] - c0 * mm) * rr + w0, t1 = (acc[ai][bj][m][1] - c1 * mm) * rr + w1;
#pragma unroll
                    for (int i = 0; i < 4; ++i) { t0[i] = sigmoidf_(t0[i]); t1[i] = sigmoidf_(t1[i]); }
                    const f32x4 x0 = (y0 - mm) * rr * g0 + b0 + t0 * p0, x1 = (y1 - mm) * rr * g1 + b1 + t1 * p1;
                    if (LAST) { *(f32x4*)(out + tile_off + off) = x0; *(f32x4*)(out + tile_off + off + 4) = x1; }
                    else { u32x4 hi, lo; split_hilo(x0, x1, hi, lo); *(u32x4*)(xb + tile_off + off) = hi; *(u32x4*)(wlo + tile_off + off) = lo; }
                }
            }
        }
    }
};

template <int MODE, bool FOLD>
__device__ __forceinline__ void conv_item(const float* W, int K, int N, bf16_t* Bt, int n0, int k0, int klen, const float* g, const float* bvec, float* cs, float* bw, float* scr, int lane) {
    const int np = n0 + (lane & 31); int src = np;
    if (MODE == 1) { if (np < 1280) { const int hp = np & 63; if (hp < 16) src = (np & ~63) + (hp >> 1) + 8 * (hp & 1); } }
    if (MODE == 2) { const int t = np >> 8, w = np & 255; src = (w & 1) * DFF + t * 128 + (w >> 1); }
    float csacc = 0.f, bacc = 0.f;
    for (int ks = k0; ks < k0 + klen; ks += 64) {
#pragma unroll 8
        for (int i = 0; i < 32; ++i) {
            const int kk = 2 * i + (lane >> 5);
            float w = W[(size_t)(ks + kk) * N + src];
            if (FOLD) { bacc += bvec[ks + kk] * w; w *= g[ks + kk]; }
            const float r = __uint_as_float(cvt_pk_c(w, 0.f) << 16);
            if (FOLD) csacc += r;
            scr[kk * 33 + (lane & 31)] = r;
        }
        asm volatile("s_waitcnt lgkmcnt(0)" ::: "memory");
        const int c = lane & 7;
#pragma unroll
        for (int j = 0; j < 4; ++j) {
            const int n = (lane >> 3) + 8 * j; const float* s = scr + (8 * c) * 33 + n;
            u32x4 o; o.x = cvt_pk_bf16(s[0 * 33], s[1 * 33]); o.y = cvt_pk_bf16(s[2 * 33], s[3 * 33]); o.z = cvt_pk_bf16(s[4 * 33], s[5 * 33]); o.w = cvt_pk_bf16(s[6 * 33], s[7 * 33]);
            *(u32x4*)(Bt + (size_t)(n0 + n) * K + ks + 8 * c) = o;
        }
        asm volatile("s_waitcnt lgkmcnt(0)" ::: "memory");
    }
    if (FOLD) {
        csacc += __shfl_xor(csacc, 32); bacc += __shfl_xor(bacc, 32);
        if (lane < 32) { cs[np] = csacc; bw[np] = bacc; }
    }
}

__device__ __forceinline__ void cvt_f32_bf16(const float* src, bf16_t* dst, size_t n, size_t gt, size_t GT) {
    for (size_t i = gt * 8; i < n; i += GT * 8) { const f32x4 a = *(const f32x4*)(src + i), b = *(const f32x4*)(src + i + 4); *(u32x4*)(dst + i) = pack8(a, b); }
}

__device__ __forceinline__ void vec_finalize(unsigned char* ws, int G, int blk) {
    const float* vecp = (const float*)(ws + WS_VECP); float* vec = (float*)(ws + WS_VEC);
    for (int i = blk * 512 + threadIdx.x; i < 13312; i += G * 512) { float a = 0.f;
#pragma unroll
        for (int kb = 0; kb < 16; ++kb) a += vecp[(size_t)kb * 13312 + i];
        vec[i] = a; }
}
struct Ptrs {
    const float *x, *p, *att_wqkv, *att_sink, *att_wo, *hg_win, *hg_lb, *hg_ng, *hg_wo, *lnm_g, *lnm_b, *ffn_win, *ffn_wout, *lnf_g, *lnf_b, *ple_wg, *ple_wp;
    float* out; unsigned char* ws;
};

typedef const Ptrs __attribute__((address_space(4)))* KP;
__device__ __forceinline__ void wconv_phase(KP Pk, int L, unsigned char* lds, int G, int blk) {
#define P (*Pk)
    int tid_l = threadIdx.x; asm volatile("" : "+v"(tid_l)); const int tid = tid_l, lane = tid & 63, wid = __builtin_amdgcn_readfirstlane(tid >> 6), j = L >> 1; const bool att = (L & 1) == 0;
    float* scr = (float*)(lds + wid * 16384);
    unsigned char* ws = P.ws;
    bf16_t *WIN = (bf16_t*)(ws + WS_WIN), *WOUT = (bf16_t*)(ws + WS_WOUT), *W1 = (bf16_t*)(ws + WS_W1), *W2 = (bf16_t*)(ws + WS_W2), *WG = (bf16_t*)(ws + WS_WG), *WP = (bf16_t*)(ws + WS_WP);
    float* vecp = (float*)(ws + WS_VECP);
    const int nin = att ? NQKV / 32 : HIN / 32;
    const int I0 = nin * 16, I1 = I0 + 32 * 16, I2 = I1 + 176 * 16, I3 = I2 + 32 * 44, I4 = I3 + 32 * 16, I5 = I4 + 32 * 4;
    for (int it = wid * G + blk; it < I5; it += 8 * G) {
        if (it < I0) { const int nb = it >> 4, kb = it & 15; if (att) conv_item<1, false>(P.att_wqkv + (size_t)j * D * NQKV, D, NQKV, WIN, nb * 32, kb * 64, 64, nullptr, nullptr, nullptr, nullptr, scr, lane);
                       else conv_item<0, false>(P.hg_win + (size_t)j * D * HIN, D, HIN, WIN, nb * 32, kb * 64, 64, nullptr, nullptr, nullptr, nullptr, scr, lane); }
        else if (it < I1) { const int r = it - I0, nb = r >> 4, kb = r & 15; conv_item<0, false>((att ? P.att_wo : P.hg_wo) + (size_t)j * D * D, D, D, WOUT, nb * 32, kb * 64, 64, nullptr, nullptr, nullptr, nullptr, scr, lane); }
        else if (it < I2) { const int r = it - I1, nb = r >> 4, kb = r & 15; float* vp = vecp + (size_t)kb * 13312; conv_item<2, true>(P.ffn_win + (size_t)L * D * 2 * DFF, D, 2 * DFF, W1, nb * 32, kb * 64, 64, P.lnm_g + L * D, P.lnm_b + L * D, vp, vp + 5632, scr, lane); }
        else if (it < I3) { const int r = it - I2, nb = r / 44, kb = r % 44; conv_item<0, false>(P.ffn_wout + (size_t)L * DFF * D, DFF, D, W2, nb * 32, kb * 64, 64, nullptr, nullptr, nullptr, nullptr, scr, lane); }
        else if (it < I4) { const int r = it - I3, nb = r >> 4, kb = r & 15; float* vp = vecp + (size_t)kb * 13312; conv_item<0, true>(P.ple_wg + (size_t)L * D * D, D, D, WG, nb * 32, kb * 64, 64, P.lnf_g + L * D, P.lnf_b + L * D, vp + 11264, vp + 12288, scr, lane); }
        else { const int r = it - I4, nb = r >> 2, kb = r & 3; conv_item<0, false>(P.ple_wp + (size_t)L * PLE * D, PLE, D, WP, nb * 32, kb * 64, 64, nullptr, nullptr, nullptr, nullptr, scr, lane); }
    }
    const size_t gt = (size_t)blk * 512 + tid, GT = (size_t)G * 512;
    cvt_f32_bf16(P.p + (size_t)L * M * PLE, (bf16_t*)(ws + WS_PB), (size_t)M * PLE, gt, GT);
    if (L == 0) {
        cvt_f32_bf16(P.x, (bf16_t*)(ws + WS_XBX), (size_t)M * D, gt, GT);
        float* rope = (float*)(ws + WS_ROPE);
        for (size_t i = gt; i < (size_t)SEQ * 8; i += GT) {
            const int pos = (int)(i >> 3), fi = (int)(i & 7);
            const float invs[8] = {1.0f, 0x1.8d275ep-3f, 0x1.34119p-5f, 0x1.ddee9cp-8f, 0x1.72ba44p-10f, 0x1.1f91fp-12f, 0x1.be218ap-15f, 0x1.5a0f5p-17f};
            float inv = invs[0];
#pragma unroll
            for (int q = 1; q < 8; ++q) inv = (fi == q) ? invs[q] : inv;
            const float ang = (float)pos * inv;
            const double rev = (double)ang * 0.15915494309189535; const double fr = rev - __builtin_rint(rev);
            const float x = (float)fr;
            rope[i] = __builtin_amdgcn_cosf(x); rope[(size_t)SEQ * 8 + i] = __builtin_amdgcn_sinf(x);
        }
    }
    if (!att) {
        float* lb = (float*)(ws + WS_LB);
        for (size_t i = gt; i < 2048; i += GT) {
            float v[4], mx = -1e30f;
#pragma unroll
            for (int d = 0; d < 4; ++d) { v[d] = P.hg_lb[(size_t)d * 2048 + i]; mx = fmaxf(mx, v[d]); }
            float den = 0.f, num = 0.f;
#pragma unroll
            for (int d = 0; d < 4; ++d) { const float e = __expf(v[d] - mx); den += e; if (d >= 1 && d <= L) num += e; }
            lb[i] = num / den;
        }
    }
#undef P
}

__device__ __forceinline__ int crow(int r, int hi) { return (r & 3) + 8 * (r >> 2) + 4 * hi; }
__device__ __forceinline__ void attn_phase(unsigned char* lds, const bf16_t* Q, const bf16_t* Kb, const bf16_t* Vb, bf16_t* O, const float* sink, int G, int blk) {
    int tid_l = threadIdx.x; asm volatile("" : "+v"(tid_l)); const int tid = tid_l, lane = tid & 63, wid = __builtin_amdgcn_readfirstlane(tid >> 6), r32 = lane & 31, hi = lane >> 5;
    bf16_t* Ks = (bf16_t*)lds; bf16_t* Vt = (bf16_t*)(lds + 384 * 72 * 2);
    for (int unit = blk; unit < 1024; unit += G) {
        const int b = unit >> 9, kvh = (unit >> 7) & 3, qb = unit & 127, start = qb * 128;
        __syncthreads();
        for (int idx = tid; idx < 384 * 8; idx += 512) {
            const int key = idx >> 3, ch = idx & 7, kpos = start - 128 + key;
            if (kpos >= 0 && kpos < SEQ) {
                const size_t gofs = ((size_t)(b * SEQ + kpos)) * 256 + kvh * 64 + ch * 8;
                const u32x4 kv = *(const u32x4*)(Kb + gofs); *(u32x4*)(Ks + key * 72 + ch * 8) = kv;
                const u32x4 vv = *(const u32x4*)(Vb + gofs);
#pragma unroll
                for (int jj = 0; jj < 4; ++jj) { const unsigned w = vv[jj]; Vt[(ch * 8 + 2 * jj) * 392 + key] = (bf16_t)(w & 0xffffu); Vt[(ch * 8 + 2 * jj + 1) * 392 + key] = (bf16_t)(w >> 16); }
            }
        }
        __syncthreads();
        const int g = wid >> 1, half = wid & 1, head = kvh * 4 + g;
        const float sk = sink[head] * LOG2E;
        for (int sb = 0; sb < 2; ++sb) {
            const int r0 = 64 * half + 32 * sb; const size_t tok = (size_t)b * SEQ + start + r0 + r32;
            bf16x8 qf[4];
#pragma unroll
            for (int ks = 0; ks < 4; ++ks) qf[ks] = *(const bf16x8*)(Q + tok * 1024 + head * 64 + 16 * ks + 8 * hi);
            float m = sk, l = 1.f; f32x16 o0 = {}, o1 = {};
            const int base_pos = start - 128 + r0;
            const int jlo = base_pos < 0 ? ((-base_pos + 31) >> 5) : 0, jhi = (SEQ - base_pos) >= 288 ? 9 : ((SEQ - base_pos) >> 5);
            bf16x8 kc[4];
#pragma unroll
            for (int ks = 0; ks < 4; ++ks) kc[ks] = *(const bf16x8*)(Ks + (r0 + 32 * jlo + r32) * 72 + 16 * ks + 8 * hi);
            for (int j = jlo; j < jhi; ++j) {
                const int key0 = r0 + 32 * j;
                bf16x8 kn[4];
                const int keyn = (j + 1 < jhi) ? key0 + 32 : key0;
#pragma unroll
                for (int ks = 0; ks < 4; ++ks) kn[ks] = *(const bf16x8*)(Ks + (keyn + r32) * 72 + 16 * ks + 8 * hi);
                u32x2 va[2][4];
#pragma unroll
                for (int s2 = 0; s2 < 2; ++s2) { const bf16_t* v0 = Vt + r32 * 392 + key0 + 16 * s2 + 4 * hi;
                    va[s2][0] = *(const u32x2*)v0; va[s2][1] = *(const u32x2*)(v0 + 8); va[s2][2] = *(const u32x2*)(v0 + 32 * 392); va[s2][3] = *(const u32x2*)(v0 + 32 * 392 + 8); }
                __builtin_amdgcn_sched_barrier(0);
                f32x16 s = {};
#pragma unroll
                for (int ks = 0; ks < 4; ++ks) s = __builtin_amdgcn_mfma_f32_32x32x16_bf16(kc[ks], qf[ks], s, 0, 0, 0);
                if (j == 0) {
#pragma unroll
                    for (int r = 0; r < 16; ++r) if (crow(r, hi) < r32) s[r] = -INFINITY;
                }
                if (j == 8) {
#pragma unroll
                    for (int r = 0; r < 16; ++r) if (crow(r, hi) > r32) s[r] = -INFINITY;
                }
                float mx = s[0];
#pragma unroll
                for (int r = 1; r < 16; ++r) mx = fmaxf(mx, s[r]);
                mx = fmaxf(mx, __shfl_xor(mx, 32));
                const float mn = fmaxf(m, mx), al = __builtin_amdgcn_exp2f(m - mn);
                float rsum = 0.f;
#pragma unroll
                for (int r = 0; r < 16; ++r) { s[r] = __builtin_amdgcn_exp2f(s[r] - mn); rsum += s[r]; }
                rsum += __shfl_xor(rsum, 32);
                l = l * al + rsum; m = mn;
#pragma unroll
                for (int r = 0; r < 16; ++r) { o0[r] *= al; o1[r] *= al; }
                bf16x8 pf[2];
#pragma unroll
                for (int s2 = 0; s2 < 2; ++s2) { u32x4 w; w.x = cvt_pk_bf16(s[8 * s2 + 0], s[8 * s2 + 1]); w.y = cvt_pk_bf16(s[8 * s2 + 2], s[8 * s2 + 3]); w.z = cvt_pk_bf16(s[8 * s2 + 4], s[8 * s2 + 5]); w.w = cvt_pk_bf16(s[8 * s2 + 6], s[8 * s2 + 7]); pf[s2] = __builtin_bit_cast(bf16x8, w); }
#pragma unroll
                for (int s2 = 0; s2 < 2; ++s2) {
                    const u32x4 A0 = {va[s2][0].x, va[s2][0].y, va[s2][1].x, va[s2][1].y}, A1 = {va[s2][2].x, va[s2][2].y, va[s2][3].x, va[s2][3].y};
                    o0 = __builtin_amdgcn_mfma_f32_32x32x16_bf16(__builtin_bit_cast(bf16x8, A0), pf[s2], o0, 0, 0, 0);
                    o1 = __builtin_amdgcn_mfma_f32_32x32x16_bf16(__builtin_bit_cast(bf16x8, A1), pf[s2], o1, 0, 0, 0);
                }
#pragma unroll
                for (int ks = 0; ks < 4; ++ks) kc[ks] = kn[ks];
            }
            const float inv = 1.0f / l;
            bf16_t* op = O + tok * 1024 + head * 64 + 4 * hi;
#pragma unroll
            for (int g4 = 0; g4 < 4; ++g4) {
                u32x2 w0, w1;
                w0.x = cvt_pk_bf16(o0[4 * g4] * inv, o0[4 * g4 + 1] * inv); w0.y = cvt_pk_bf16(o0[4 * g4 + 2] * inv, o0[4 * g4 + 3] * inv);
                w1.x = cvt_pk_bf16(o1[4 * g4] * inv, o1[4 * g4 + 1] * inv); w1.y = cvt_pk_bf16(o1[4 * g4 + 2] * inv, o1[4 * g4 + 3] * inv);
                *(u32x2*)(op + 8 * g4) = w0; *(u32x2*)(op + 32 + 8 * g4) = w1;
            }
        }
    }
    __syncthreads();
}

constexpr size_t ZSEG = (size_t)8 * M * 128;
constexpr int HP = 136;
constexpr int L_TOT = 0, L_TOTE = 4096, L_KO = 8192, L_ST = L_KO + 128 * HP * 2, L_VT = L_ST + 128 * HP * 2, L_P = L_VT + 128 * HP * 2;
static_assert(L_P + 8 * 16 * HP * 2 - 16 <= LDS_BYTES - 16, "hgrn lds (the last 16 bytes are row padding, never touched: the grid barrier words live there)");
#define SCAN_STEP(ctrl, sh) asm volatile("s_nop 1\n\t" \
    "v_add_f32_dpp %0, %0, %0 " ctrl #sh " row_mask:0xf bank_mask:0xf bound_ctrl:1\n\tv_add_f32_dpp %1, %1, %1 " ctrl #sh " row_mask:0xf bank_mask:0xf bound_ctrl:1\n\t" \
    "v_add_f32_dpp %2, %2, %2 " ctrl #sh " row_mask:0xf bank_mask:0xf bound_ctrl:1\n\tv_add_f32_dpp %3, %3, %3 " ctrl #sh " row_mask:0xf bank_mask:0xf bound_ctrl:1\n\t" \
    "v_add_f32_dpp %4, %4, %4 " ctrl #sh " row_mask:0xf bank_mask:0xf bound_ctrl:1\n\tv_add_f32_dpp %5, %5, %5 " ctrl #sh " row_mask:0xf bank_mask:0xf bound_ctrl:1\n\t" \
    "v_add_f32_dpp %6, %6, %6 " ctrl #sh " row_mask:0xf bank_mask:0xf bound_ctrl:1\n\tv_add_f32_dpp %7, %7, %7 " ctrl #sh " row_mask:0xf bank_mask:0xf bound_ctrl:1" \
    : "+v"(v[0]), "+v"(v[1]), "+v"(v[2]), "+v"(v[3]), "+v"(v[4]), "+v"(v[5]), "+v"(v[6]), "+v"(v[7]))
template <int DIR> __device__ __forceinline__ void scan16x8(float* v) {
    if (DIR == 0) { SCAN_STEP("row_shr:", 1); SCAN_STEP("row_shr:", 2); SCAN_STEP("row_shr:", 4); SCAN_STEP("row_shr:", 8); }
    else          { SCAN_STEP("row_shl:", 1); SCAN_STEP("row_shl:", 2); SCAN_STEP("row_shl:", 4); SCAN_STEP("row_shl:", 8); }
}
__device__ __forceinline__ void load32(const bf16_t* p, float (&v)[32]) {
#pragma unroll
    for (int ks = 0; ks < 4; ++ks) { const u32x4 w = *(const u32x4*)(p + 32 * ks);
        v[8 * ks + 0] = bf_lo(w.x); v[8 * ks + 1] = bf_hi(w.x); v[8 * ks + 2] = bf_lo(w.y); v[8 * ks + 3] = bf_hi(w.y); v[8 * ks + 4] = bf_lo(w.z); v[8 * ks + 5] = bf_hi(w.z); v[8 * ks + 6] = bf_lo(w.w); v[8 * ks + 7] = bf_hi(w.w); }
}
__device__ __forceinline__ bf16x8 pk8(const float* v) { u32x4 w; w.x = cvt_pk_bf16(v[0], v[1]); w.y = cvt_pk_bf16(v[2], v[3]); w.z = cvt_pk_bf16(v[4], v[5]); w.w = cvt_pk_bf16(v[6], v[7]); return __builtin_bit_cast(bf16x8, w); }
#define WAVE_LDS_FENCE() do { asm volatile("s_waitcnt lgkmcnt(0)" ::: "memory"); __builtin_amdgcn_wave_barrier(); } while (0)

template <int DIR> __device__ __forceinline__ void h1_dir(unsigned char* lds, const bf16_t* zrow, int h, bf16_t* slot, float* decp) {
    int tid_l = threadIdx.x; asm volatile("" : "+v"(tid_l)); const int tid = tid_l, lane = tid & 63, wid = __builtin_amdgcn_readfirstlane(tid >> 6), r = lane & 15, kq = lane >> 4;
    float* TOT = (float*)(lds + L_TOT); bf16_t* KS = (bf16_t*)(lds + L_KO); bf16_t* VT = (bf16_t*)(lds + L_VT); bf16_t* STG = (bf16_t*)(lds + L_ST);
    float bl[32], kk[32];
    load32(zrow + (size_t)(1 + DIR) * ZSEG + 8 * kq, bl);
#pragma unroll
    for (int i = 0; i < 32; ++i) kk[i] = 1.0f - __builtin_amdgcn_exp2f(bl[i]);
        scan16x8<DIR>(bl); scan16x8<DIR>(bl + 8); scan16x8<DIR>(bl + 16); scan16x8<DIR>(bl + 24);
    if (r == (DIR ? 0 : 15)) {
#pragma unroll
        for (int ks = 0; ks < 4; ++ks) { *(f32x4*)(TOT + wid * 128 + 32 * ks + 8 * kq) = (f32x4){bl[8 * ks], bl[8 * ks + 1], bl[8 * ks + 2], bl[8 * ks + 3]}; *(f32x4*)(TOT + wid * 128 + 32 * ks + 8 * kq + 4) = (f32x4){bl[8 * ks + 4], bl[8 * ks + 5], bl[8 * ks + 6], bl[8 * ks + 7]}; }
    }
    __syncthreads();
    {
        float aft[32];
#pragma unroll
        for (int i = 0; i < 32; ++i) aft[i] = 0.f;
        for (int m = 0; m < 8; ++m) {
            const bool use = DIR ? (m <= wid) : (m >= wid);
            if (use) {
#pragma unroll
                for (int ks = 0; ks < 4; ++ks) { const f32x4 a = *(const f32x4*)(TOT + m * 128 + 32 * ks + 8 * kq), b = *(const f32x4*)(TOT + m * 128 + 32 * ks + 8 * kq + 4);
                    aft[8 * ks] += a[0]; aft[8 * ks + 1] += a[1]; aft[8 * ks + 2] += a[2]; aft[8 * ks + 3] += a[3]; aft[8 * ks + 4] += b[0]; aft[8 * ks + 5] += b[1]; aft[8 * ks + 6] += b[2]; aft[8 * ks + 7] += b[3]; }
            }
        }
        if (wid == (DIR ? 7 : 0) && r == 0) {
#pragma unroll
            for (int ks = 0; ks < 4; ++ks)
#pragma unroll
                for (int e = 0; e < 8; ++e) decp[32 * ks + 8 * kq + e] = __builtin_amdgcn_exp2f(aft[8 * ks + e]);
        }
#pragma unroll
        for (int ks = 0; ks < 4; ++ks)
#pragma unroll
            for (int e = 0; e < 8; e += 2) { const unsigned w = cvt_pk_c(kk[8 * ks + e] * __builtin_amdgcn_exp2f(aft[8 * ks + e] - bl[8 * ks + e]), kk[8 * ks + e + 1] * __builtin_amdgcn_exp2f(aft[8 * ks + e + 1] - bl[8 * ks + e + 1]));
                KS[(32 * ks + 8 * kq + e) * HP + 16 * wid + r] = (bf16_t)(w & 0xffffu); KS[(32 * ks + 8 * kq + e + 1) * HP + 16 * wid + r] = (bf16_t)(w >> 16); }
    }
    __syncthreads();
    f32x4 acc[8];
#pragma unroll
    for (int nt = 0; nt < 8; ++nt) acc[nt] = (f32x4){0.f, 0.f, 0.f, 0.f};
#pragma unroll
    for (int ks = 0; ks < 4; ++ks) {
        const bf16x8 a = *(const bf16x8*)(VT + (16 * wid + r) * HP + 32 * ks + 8 * kq);
#pragma unroll
        for (int nt = 0; nt < 8; ++nt) { const bf16x8 bb = *(const bf16x8*)(KS + (16 * nt + r) * HP + 32 * ks + 8 * kq); acc[nt] = __builtin_amdgcn_mfma_f32_16x16x32_bf16(a, bb, acc[nt], 0, 0, 0); }
    }
#pragma unroll
    for (int nt = 0; nt < 8; ++nt)
#pragma unroll
        for (int i = 0; i < 4; i += 2) { const unsigned w = cvt_pk_c(acc[nt][i], acc[nt][i + 1]); STG[(16 * wid + 4 * kq + i) * HP + 16 * nt + r] = (bf16_t)(w & 0xffffu); STG[(16 * wid + 4 * kq + i + 1) * HP + 16 * nt + r] = (bf16_t)(w >> 16); }
    WAVE_LDS_FENCE();
#pragma unroll
    for (int it = 0; it < 4; ++it) { const int p = lane + 64 * it, row = p >> 4, c16 = p & 15; *(u32x4*)(slot + (size_t)(16 * wid + row) * 128 + c16 * 8) = *(const u32x4*)(STG + (16 * wid + row) * HP + c16 * 8); }
    __syncthreads();
}
__device__ __forceinline__ void h1_phase(unsigned char* lds, unsigned char* ws, bf16_t* SF, int G, int blk) {
    int tid_l = threadIdx.x; asm volatile("" : "+v"(tid_l)); const int tid = tid_l, lane = tid & 63, wid = __builtin_amdgcn_readfirstlane(tid >> 6), r = lane & 15, kq = lane >> 4;
    const bf16_t* Z = (const bf16_t*)(ws + WS_Z); bf16_t* VT = (bf16_t*)(lds + L_VT);
    for (int unit = blk; unit < 2048; unit += G) {
        const int b = unit >> 10, c = (unit >> 3) & 127, h = unit & 7, chain = b * 8 + h;
        const bf16_t* zrow = Z + ((size_t)h * M + (size_t)b * SEQ + c * 128 + 16 * wid + r) * 128;
        {
#pragma unroll
          for (int ks = 0; ks < 4; ++ks) { const u32x4 w = *(const u32x4*)(zrow + 3 * ZSEG + 8 * kq + 32 * ks);
#pragma unroll
              for (int e = 0; e < 4; ++e) { VT[(32 * ks + 8 * kq + 2 * e) * HP + 16 * wid + r] = (bf16_t)(w[e] & 0xffffu); VT[(32 * ks + 8 * kq + 2 * e + 1) * HP + 16 * wid + r] = (bf16_t)(w[e] >> 16); } } }
        h1_dir<0>(lds, zrow, h, SF + ((size_t)chain * 128 + c) * 16384, (float*)(ws + WS_DEC) + ((size_t)(0 * 16 + chain) * 128 + c) * 128);
        h1_dir<1>(lds, zrow, h, (bf16_t*)(ws + WS_SB) + ((size_t)chain * 128 + c) * 16384, (float*)(ws + WS_DEC) + ((size_t)(1 * 16 + chain) * 128 + c) * 128);
    }
}
__device__ __forceinline__ void h2_phase(unsigned char* ws, bf16_t* SF, int G, int blk) {
    int tid_l = threadIdx.x; asm volatile("" : "+v"(tid_l));
    const size_t gt = (size_t)blk * 512 + tid_l, GT = (size_t)G * 512;
    for (size_t w = gt; w < (size_t)32 * 4096; w += GT) {
        const int ch32 = (int)(w >> 12), dir = ch32 >> 4, chain = ch32 & 15, e4 = (int)(w & 4095);
        bf16_t* base = (dir ? (bf16_t*)(ws + WS_SB) : SF) + (size_t)chain * 128 * 16384 + (size_t)e4 * 4;
        const float* dbase = (const float*)(ws + WS_DEC) + ((size_t)(dir * 16 + chain) * 128) * 128 + ((e4 * 4) & 127);
        f32x4 S = {0.f, 0.f, 0.f, 0.f};
        for (int s0 = 0; s0 < 128; s0 += 8) {
            u32x2 raw[8]; f32x4 dd[8];
#pragma unroll
            for (int k = 0; k < 8; ++k) { const int c = dir ? 127 - (s0 + k) : (s0 + k); raw[k] = *(const u32x2*)(base + (size_t)c * 16384); dd[k] = *(const f32x4*)(dbase + (size_t)c * 128); }
#pragma unroll
            for (int k = 0; k < 8; ++k) { const int c = dir ? 127 - (s0 + k) : (s0 + k);
                u32x2 o; o.x = cvt_pk_bf16(S[0], S[1]); o.y = cvt_pk_bf16(S[2], S[3]); *(u32x2*)(base + (size_t)c * 16384) = o;
                const f32x4 ds = {bf_lo(raw[k].x), bf_hi(raw[k].x), bf_lo(raw[k].y), bf_hi(raw[k].y)}; S = dd[k] * S + ds; }
        }
    }
}
template <int DIR> __device__ __forceinline__ void h3_dir(unsigned char* lds, const bf16_t* zrow, int h, const bf16_t* slot, f32x4 (&o)[8]) {
    int tid_l = threadIdx.x; asm volatile("" : "+v"(tid_l)); const int tid = tid_l, lane = tid & 63, wid = __builtin_amdgcn_readfirstlane(tid >> 6), r = lane & 15, kq = lane >> 4;
    float* TOT = (float*)(lds + L_TOT); float* TOTE = (float*)(lds + L_TOTE); bf16_t* KO = (bf16_t*)(lds + L_KO); bf16_t* ST = (bf16_t*)(lds + L_ST); const bf16_t* VT = (const bf16_t*)(lds + L_VT); bf16_t* Pw = (bf16_t*)(lds + L_P) + wid * 16 * HP;
    float bl[32], qin[32]; bf16x8 kin[4];
    load32(zrow + (size_t)(1 + DIR) * ZSEG + 8 * kq, bl);
    load32(zrow + 8 * kq, qin);
    {
        float kk[32];
#pragma unroll
        for (int i = 0; i < 32; ++i) kk[i] = 1.0f - __builtin_amdgcn_exp2f(bl[i]);
        scan16x8<DIR>(bl); scan16x8<DIR>(bl + 8); scan16x8<DIR>(bl + 16); scan16x8<DIR>(bl + 24);
        float eb[32];
#pragma unroll
        for (int i = 0; i < 32; ++i) { eb[i] = __builtin_amdgcn_exp2f(bl[i]); qin[i] *= eb[i]; }
        if (r == (DIR ? 0 : 15)) {
#pragma unroll
            for (int ks = 0; ks < 4; ++ks) { *(f32x4*)(TOT + wid * 128 + 32 * ks + 8 * kq) = (f32x4){bl[8 * ks], bl[8 * ks + 1], bl[8 * ks + 2], bl[8 * ks + 3]}; *(f32x4*)(TOT + wid * 128 + 32 * ks + 8 * kq + 4) = (f32x4){bl[8 * ks + 4], bl[8 * ks + 5], bl[8 * ks + 6], bl[8 * ks + 7]}; }
#pragma unroll
            for (int ks = 0; ks < 4; ++ks) { *(f32x4*)(TOTE + wid * 128 + 32 * ks + 8 * kq) = (f32x4){eb[8 * ks], eb[8 * ks + 1], eb[8 * ks + 2], eb[8 * ks + 3]}; *(f32x4*)(TOTE + wid * 128 + 32 * ks + 8 * kq + 4) = (f32x4){eb[8 * ks + 4], eb[8 * ks + 5], eb[8 * ks + 6], eb[8 * ks + 7]}; }
        }
#pragma unroll
        for (int it = 0; it < 4; ++it) { const int p = tid + 512 * it, v = p >> 4, c16 = p & 15; *(u32x4*)(ST + v * HP + c16 * 8) = *(const u32x4*)(slot + (size_t)v * 128 + c16 * 8); }
#pragma unroll
        for (int it = 0; it < 4; ++it) { const int p = lane + 64 * it; *(u32x4*)(Pw + (p >> 4) * HP + (p & 15) * 8) = (u32x4){0u, 0u, 0u, 0u}; }
        __syncthreads();
        float tmp[8];
#pragma unroll
        for (int ks = 0; ks < 4; ++ks) {
            const f32x4 a = *(const f32x4*)(TOT + wid * 128 + 32 * ks + 8 * kq), b = *(const f32x4*)(TOT + wid * 128 + 32 * ks + 8 * kq + 4);
            const float tw[8] = {a[0], a[1], a[2], a[3], b[0], b[1], b[2], b[3]};
#pragma unroll
            for (int e = 0; e < 8; ++e) tmp[e] = kk[8 * ks + e] * __builtin_amdgcn_exp2f(tw[e] - bl[8 * ks + e]);
            *(bf16x8*)(KO + (16 * wid + r) * HP + 32 * ks + 8 * kq) = pk8(tmp);
#pragma unroll
            for (int e = 0; e < 8; ++e) tmp[e] = kk[8 * ks + e] * __builtin_amdgcn_exp2f(fminf(-bl[8 * ks + e], 115.f));
            kin[ks] = pk8(tmp);
        }
    }
    __syncthreads();
    {
        f32x4 sc = {0.f, 0.f, 0.f, 0.f};
#pragma unroll
        for (int ks = 0; ks < 4; ++ks) sc = __builtin_amdgcn_mfma_f32_16x16x32_bf16(pk8(qin + 8 * ks), kin[ks], sc, 0, 0, 0);
#pragma unroll
        for (int i = 0; i < 4; i += 2) { const int t = 4 * kq + i; const bool k0 = DIR ? (r >= t) : (r <= t), k1 = DIR ? (r >= t + 1) : (r <= t + 1); const unsigned w = cvt_pk_c(k0 ? sc[i] : 0.f, k1 ? sc[i + 1] : 0.f);
            Pw[t * HP + 16 * wid + r] = (bf16_t)(w & 0xffffu); Pw[(t + 1) * HP + 16 * wid + r] = (bf16_t)(w >> 16); }
    }
    float run[32];
#pragma unroll
    for (int i = 0; i < 32; ++i) run[i] = 1.f;
    for (int d = 1; d < 8; ++d) {
        const int m = DIR ? wid + d : wid - d;
        if (m < 0 || m > 7) break;
        f32x4 sc = {0.f, 0.f, 0.f, 0.f};
#pragma unroll
        for (int ks = 0; ks < 4; ++ks) {
            float tmp[8];
#pragma unroll
            for (int e = 0; e < 8; ++e) tmp[e] = qin[8 * ks + e] * run[8 * ks + e];
            const bf16x8 bb = *(const bf16x8*)(KO + (16 * m + r) * HP + 32 * ks + 8 * kq);
            sc = __builtin_amdgcn_mfma_f32_16x16x32_bf16(pk8(tmp), bb, sc, 0, 0, 0);
            const f32x4 a = *(const f32x4*)(TOTE + m * 128 + 32 * ks + 8 * kq), b = *(const f32x4*)(TOTE + m * 128 + 32 * ks + 8 * kq + 4);
            run[8 * ks] *= a[0]; run[8 * ks + 1] *= a[1]; run[8 * ks + 2] *= a[2]; run[8 * ks + 3] *= a[3]; run[8 * ks + 4] *= b[0]; run[8 * ks + 5] *= b[1]; run[8 * ks + 6] *= b[2]; run[8 * ks + 7] *= b[3];
        }
#pragma unroll
        for (int i = 0; i < 4; i += 2) { const unsigned w = cvt_pk_c(sc[i], sc[i + 1]); Pw[(4 * kq + i) * HP + 16 * m + r] = (bf16_t)(w & 0xffffu); Pw[(4 * kq + i + 1) * HP + 16 * m + r] = (bf16_t)(w >> 16); }
    }
#pragma unroll
    for (int i = 0; i < 32; ++i) qin[i] *= run[i];
    WAVE_LDS_FENCE();
#pragma unroll
    for (int ks = 0; ks < 4; ++ks) {
        const bf16x8 aq = pk8(qin + 8 * ks), ap = *(const bf16x8*)(Pw + r * HP + 32 * ks + 8 * kq);
#pragma unroll
        for (int nt = 0; nt < 8; ++nt) {
            o[nt] = __builtin_amdgcn_mfma_f32_16x16x32_bf16(aq, *(const bf16x8*)(ST + (16 * nt + r) * HP + 32 * ks + 8 * kq), o[nt], 0, 0, 0);
            o[nt] = __builtin_amdgcn_mfma_f32_16x16x32_bf16(ap, *(const bf16x8*)(VT + (16 * nt + r) * HP + 32 * ks + 8 * kq), o[nt], 0, 0, 0);
        }
    }
    __syncthreads();
}
template <bool STORE> __device__ __forceinline__ void h3_phase(unsigned char* lds, unsigned char* ws, const bf16_t* SF, const float* norm_g, int G, int blk) {
    int tid_l = threadIdx.x; asm volatile("" : "+v"(tid_l)); const int tid = tid_l, lane = tid & 63, wid = __builtin_amdgcn_readfirstlane(tid >> 6), r = lane & 15, kq = lane >> 4;
    bf16_t* Z = (bf16_t*)(ws + WS_Z); bf16_t* VT = (bf16_t*)(lds + L_VT); float* STGF = (float*)(lds + L_KO) + wid * 16 * 132;
    for (int unit = blk; unit < 2048; unit += G) {
        const int b = unit >> 10, c = (unit >> 3) & 127, h = unit & 7, chain = b * 8 + h;
        const size_t tok0 = (size_t)b * SEQ + c * 128 + 16 * wid;
        const bf16_t* zrow = Z + ((size_t)h * M + tok0 + r) * 128;
        {
#pragma unroll
          for (int ks = 0; ks < 4; ++ks) { const u32x4 w = *(const u32x4*)(zrow + 3 * ZSEG + 8 * kq + 32 * ks);
#pragma unroll
              for (int e = 0; e < 4; ++e) { VT[(32 * ks + 8 * kq + 2 * e) * HP + 16 * wid + r] = (bf16_t)(w[e] & 0xffffu); VT[(32 * ks + 8 * kq + 2 * e + 1) * HP + 16 * wid + r] = (bf16_t)(w[e] >> 16); } } }
        f32x4 o[8];
#pragma unroll
        for (int nt = 0; nt < 8; ++nt) o[nt] = (f32x4){0.f, 0.f, 0.f, 0.f};
        h3_dir<0>(lds, zrow, h, SF + ((size_t)chain * 128 + c) * 16384, o);
        h3_dir<1>(lds, zrow, h, (const bf16_t*)(ws + WS_SB) + ((size_t)chain * 128 + c) * 16384, o);
        float ssq[4];
#pragma unroll
        for (int i = 0; i < 4; ++i) { float s = 0.f;
#pragma unroll
            for (int nt = 0; nt < 8; ++nt) s += o[nt][i] * o[nt][i];
            s += __shfl_xor(s, 1); s += __shfl_xor(s, 2); s += __shfl_xor(s, 4); s += __shfl_xor(s, 8);
            ssq[i] = 1.0f / sqrtf(s * (1.0f / 128.0f) + LN_EPS); }
#pragma unroll
        for (int nt = 0; nt < 8; ++nt)
#pragma unroll
            for (int i = 0; i < 4; ++i) STGF[(4 * kq + i) * 132 + 16 * nt + r] = o[nt][i] * ssq[i];
        WAVE_LDS_FENCE();
#pragma unroll
        for (int it = 0; it < 4; ++it) {
            const int p = lane + 64 * it, row = p >> 4, c8 = p & 15;
            const f32x4 a = *(const f32x4*)(STGF + row * 132 + c8 * 8), bq = *(const f32x4*)(STGF + row * 132 + c8 * 8 + 4);
            const f32x4 g0 = *(const f32x4*)(norm_g + c8 * 8), g1 = *(const f32x4*)(norm_g + c8 * 8 + 4);
            bf16_t* zr = Z + ((size_t)h * M + tok0 + row) * 128 + c8 * 8;
            const u32x4 gw = *(const u32x4*)(zr + 4 * ZSEG);
            const f32x4 t0 = {bf_lo(gw.x), bf_hi(gw.x), bf_lo(gw.y), bf_hi(gw.y)}, t1 = {bf_lo(gw.z), bf_hi(gw.z), bf_lo(gw.w), bf_hi(gw.w)};
            if (STORE || a[0] == 123.456f) *(u32x4*)zr = pack8(a * g0 * t0, bq * g1 * t1);
        }
        __syncthreads();
    }
}

#define LAS __attribute__((address_space(3)))
#define XB_TMO      128
#define XB_XCNT(j)  (256  + 64 * (j))
#define XB_XSUB(j)  (1280 + 64 * (j))
#define XB_XGEN(j)  (2304 + 64 * (j))
#define XB_TOP      3328
#define XB_TOPGEN   3392
#define XCD_BAR_WORDS 3456
#define XB_SPIN_CAP (1u << 18)

__device__ __forceinline__ unsigned xb_ld(unsigned* p)              { return __hip_atomic_load(p, __ATOMIC_RELAXED, __HIP_MEMORY_SCOPE_AGENT); }
__device__ __forceinline__ unsigned xb_add(unsigned* p, unsigned v) { return __hip_atomic_fetch_add(p, v, __ATOMIC_RELAXED, __HIP_MEMORY_SCOPE_AGENT); }
__device__ __forceinline__ unsigned xb_xcc_id() { return (unsigned)__builtin_amdgcn_s_getreg((3 << 11) | 20) & 0xFu; }
#define XB_SPIN(cond, bar) do { unsigned _sp = 0; while (cond) { __builtin_amdgcn_s_sleep(1); \
    if ((++_sp & 255u) == 0u) { if (xb_ld(&(bar)[XB_TMO])) break; if (_sp > XB_SPIN_CAP) { atomicAdd(&(bar)[XB_TMO], 1u); break; } } } } while (0)

struct XcdBarrier {
    unsigned* bar; unsigned x;
    volatile LAS unsigned* st;
};

__device__ __forceinline__ XcdBarrier xcd_barrier_post(unsigned* bar, volatile LAS unsigned* st) {
    XcdBarrier b; b.bar = bar; b.x = xb_xcc_id(); b.st = st;
    if (threadIdx.x == 0) (void)xb_add(&bar[XB_XCNT(b.x)], 1u);
    return b;
}
__device__ __forceinline__ void xcd_barrier_complete(unsigned* bar, unsigned x, unsigned& nloc, unsigned& nx) {
    const unsigned G = gridDim.x * gridDim.y * gridDim.z;
    unsigned sum, cnt, mine, sp = 0u;
    for (;;) {
        sum = 0u; cnt = 0u; mine = 0u;
#pragma unroll
        for (unsigned j = 0; j < 16; ++j) { const unsigned c = xb_ld(&bar[XB_XCNT(j)]); sum += c; cnt += (c > 0u) ? 1u : 0u; mine = (j == x) ? c : mine; }
        if (sum == G) break;
        __builtin_amdgcn_s_sleep(1);
        if ((++sp & 255u) == 0u) { if (xb_ld(&bar[XB_TMO])) break; if (sp > XB_SPIN_CAP) { atomicAdd(&bar[XB_TMO], 1u); break; } }
    }
    nloc = mine > 0u ? mine : 1u; nx = cnt > 0u ? cnt : 1u;
}

__device__ __forceinline__ void xcd_barrier(const XcdBarrier& b) {
    asm volatile("s_waitcnt vmcnt(0)" ::: "memory");
    __syncthreads();
    if (threadIdx.x == 0) {
        unsigned* bar = b.bar;
        __builtin_amdgcn_s_waitcnt(0);
        unsigned nloc = b.st[0], nx = b.st[1];
        if (nloc == 0u) { xcd_barrier_complete(bar, b.x, nloc, nx); b.st[0] = nloc; b.st[1] = nx; }
        const unsigned old = xb_add(&bar[XB_XSUB(b.x)], 1u);
        const unsigned gen = old / nloc;
        if (old + 1u == (gen + 1u) * nloc) {
            __builtin_amdgcn_fence(__ATOMIC_RELEASE, "agent");
            asm volatile("s_waitcnt vmcnt(0)" ::: "memory");
            const unsigned og = xb_add(&bar[XB_TOP], 1u);
            const unsigned tg = og / nx;
            if (og + 1u == (tg + 1u) * nx) xb_add(&bar[XB_TOPGEN], 1u);
            else XB_SPIN(xb_ld(&bar[XB_TOPGEN]) == tg, bar);
            __builtin_amdgcn_fence(__ATOMIC_ACQUIRE, "agent");
            xb_add(&bar[XB_XGEN(b.x)], 1u);
            asm volatile("s_waitcnt vmcnt(0)" ::: "memory");
        } else {
            XB_SPIN(xb_ld(&bar[XB_XGEN(b.x)]) == gen, bar);
            __builtin_amdgcn_fence(__ATOMIC_ACQUIRE, "agent");
            asm volatile("s_waitcnt vmcnt(0)" ::: "memory");
        }
    }
    __syncthreads();
}

#define GEMM_PHASE(EPI, Aptr, LDA, Bptr, LDB, NN, KK, Eobj) GEMM_PHASE_H(EPI, Aptr, LDA, 0, Bptr, LDB, NN, KK, Eobj)
#define GEMM_PHASE_H(EPI, Aptr, LDA, AHS, Bptr, LDB, NN, KK, Eobj) do { pg8::Gemm g_{(const bf16_t*)(Aptr), (const bf16_t*)(Bptr), M, (NN), (KK), (LDA), (LDB), (size_t)(AHS)}; pg8::StaticOrder S_; S_.init(M, (NN), G, blk); \
    pg8::gemm_phase<EPI, pg8::StaticOrder, true, true>((PG8_LAS unsigned char*)lds, g_, S_, (Eobj)); } while (0)

#define GSYNC() do { REP_SYNC(xcd_barrier(bar);) } while (0)
#define KPTR() KP kp = (KP)__builtin_amdgcn_kernarg_segment_ptr(); int G = gridDim.x, blk = blockIdx.x; asm volatile("" : "+s"(kp), "+s"(G), "+s"(blk)); unsigned char* ws = kp->ws; (void)ws
#define COMMA ,
template <int L> __device__ __forceinline__ void layer_fwd(unsigned char* lds, const XcdBarrier& bar) {
        constexpr int j = L >> 1; constexpr bool att = (L & 1) == 0;
        REP_WCONV({ KPTR(); wconv_phase(kp, L, lds, G, blk); })
        GSYNC();
        if (att) {
            { KPTR(); vec_finalize(ws, G, blk); EpiQKV E{(bf16_t*)(ws + WS_Q), (bf16_t*)(ws + WS_K), (bf16_t*)(ws + WS_V), (const float*)(ws + WS_ROPE)}; GEMM_PHASE(EpiQKV, ws + WS_XBX, D, ws + WS_WIN, D, NQKV, D, E); }
            GSYNC();
            REP_ATT({ KPTR(); attn_phase(lds, (const bf16_t*)(ws + WS_Q), (const bf16_t*)(ws + WS_K), (const bf16_t*)(ws + WS_V), (bf16_t*)(ws + WS_O), kp->att_sink + j * 16, G, blk); })
            GSYNC();
            { KPTR(); bf16_t* LOA = (bf16_t*)kp->out; using ER_ = EpiRes<false, L == 0>; ER_ E{kp->x, (const bf16_t*)(ws + WS_XBX), LOA, (bf16_t*)(ws + WS_XBX), LOA, (f32x2*)(ws + WS_ST1), nullptr, nullptr, nullptr}; GEMM_PHASE(ER_, ws + WS_O, D, ws + WS_WOUT, D, D, D, E); }
            GSYNC();
        } else {
            REP_HIN({ KPTR(); vec_finalize(ws, G, blk); EpiHin E{(bf16_t*)(ws + WS_Z), (const float*)(ws + WS_LB)}; GEMM_PHASE(EpiHin, ws + WS_XBX, D, ws + WS_WIN, D, HIN, D, E); })
            GSYNC();
            REP_H1({ KPTR(); h1_phase(lds, ws, (bf16_t*)kp->out + (size_t)M * D, G, blk); })
            GSYNC();
            { KPTR(); h2_phase(ws, (bf16_t*)kp->out + (size_t)M * D, G, blk); }
            GSYNC();
            REP_H3({ KPTR(); h3_phase<false>(lds, ws, (const bf16_t*)kp->out + (size_t)M * D, kp->hg_ng + j * 128, G, blk); })
            { KPTR(); h3_phase<true>(lds, ws, (const bf16_t*)kp->out + (size_t)M * D, kp->hg_ng + j * 128, G, blk); }
            GSYNC();
            { KPTR(); bf16_t* LOA = (bf16_t*)kp->out; using ER_ = EpiRes<false, false>; ER_ E{nullptr, (const bf16_t*)(ws + WS_XBX), LOA, (bf16_t*)(ws + WS_XBX), LOA, (f32x2*)(ws + WS_ST1), nullptr, nullptr, nullptr}; GEMM_PHASE_H(ER_, ws + WS_Z, 128, (size_t)M * 128 * 2, ws + WS_WOUT, D, D, D, E); }
            GSYNC();
        }
        REP_F1({ KPTR(); float* vec = (float*)(ws + WS_VEC); EpiFfn1 E{(bf16_t*)(ws + WS_H), (const f32x2*)(ws + WS_ST1), vec, vec + 5632}; GEMM_PHASE(EpiFfn1, ws + WS_XBX, D, ws + WS_W1, D, 2 * DFF, D, E); })
        { KPTR(); EpiPlain E{(bf16_t*)(ws + WS_PP), D}; GEMM_PHASE(EpiPlain, ws + WS_PB, PLE, ws + WS_WP, PLE, D, PLE, E); }
        GSYNC();
        { KPTR(); bf16_t* LOA = (bf16_t*)kp->out; bf16_t* LOW = (L == DEPTH - 1) ? (bf16_t*)(ws + WS_SB) : LOA;
          using ER_ = EpiRes<true, false>; ER_ E{nullptr, (const bf16_t*)(ws + WS_XBX), LOA, (bf16_t*)(ws + WS_XBY), LOW, (f32x2*)(ws + WS_ST2), (const f32x2*)(ws + WS_ST1), kp->lnm_g + L * D, kp->lnm_b + L * D}; GEMM_PHASE(ER_, ws + WS_H, DFF, ws + WS_W2, DFF, D, DFF, E); }
        GSYNC();
        { KPTR(); float* vec = (float*)(ws + WS_VEC); bf16_t* LOA = (bf16_t*)kp->out; const bf16_t* LOR = (L == DEPTH - 1) ? (const bf16_t*)(ws + WS_SB) : LOA;
          EpiPle<L == DEPTH - 1> E{kp->out, (const bf16_t*)(ws + WS_XBY), LOR, (bf16_t*)(ws + WS_XBX), LOA, (const f32x2*)(ws + WS_ST2), kp->lnf_g + L * D, kp->lnf_b + L * D, vec + 11264, vec + 12288, (const bf16_t*)(ws + WS_PP)}; GEMM_PHASE(EpiPle<L == DEPTH - 1>, ws + WS_XBY, D, ws + WS_WG, D, D, D, E); }
        GSYNC();
}
__global__ void __launch_bounds__(512, 2) mk_fwd(Ptrs Parg) {
    extern __shared__ __attribute__((aligned(16))) unsigned char lds[];
    cg::grid_group grid = cg::this_grid();
    volatile LAS unsigned* bst = (volatile LAS unsigned*)((LAS unsigned char*)lds + (LDS_BYTES - 16));
    if (threadIdx.x < 4) bst[threadIdx.x] = 0u;
    __syncthreads();
    XcdBarrier bar = xcd_barrier_post((unsigned*)(Parg.ws + WS_CTL), bst);
    grid.sync();
    layer_fwd<0>(lds, bar); layer_fwd<1>(lds, bar); layer_fwd<2>(lds, bar); layer_fwd<3>(lds, bar);
}

extern "C" void kernel_launch(void* const* d_in, const int* in_sizes, int n_in, void* d_out, int out_size, void* d_ws, size_t ws_size, hipStream_t stream) {
    static int grid = 0;
    if (grid == 0) {
        if (n_in != 17 || out_size != M * D || ws_size < WS_END) { fprintf(stderr, "kernel_launch: unexpected problem: n_in %d out %d ws %zu (need %zu)\n", n_in, out_size, ws_size, (size_t)WS_END); grid = -1; return; }
        int dev = 0, cus = 0, per_cu = 0;
        (void)hipGetDevice(&dev);
        (void)hipDeviceGetAttribute(&cus, hipDeviceAttributeMultiprocessorCount, dev);
        (void)hipFuncSetAttribute((const void*)mk_fwd, hipFuncAttributeMaxDynamicSharedMemorySize, LDS_BYTES);
        (void)hipOccupancyMaxActiveBlocksPerMultiprocessor(&per_cu, (const void*)mk_fwd, 512, LDS_BYTES);
        if (per_cu < 1) fprintf(stderr, "kernel_launch: occupancy query says %d blocks/CU\n", per_cu);
        (void)hipGetLastError();
        grid = cus;
    }
    if (grid < 0) return;
    (void)hipMemsetAsync((char*)d_ws + WS_CTL, 0, CTL_ZERO_BYTES, stream);
    Ptrs p{};
    p.x = (const float*)d_in[0]; p.p = (const float*)d_in[1]; p.att_wqkv = (const float*)d_in[2]; p.att_sink = (const float*)d_in[3]; p.att_wo = (const float*)d_in[4];
    p.hg_win = (const float*)d_in[5]; p.hg_lb = (const float*)d_in[6]; p.hg_ng = (const float*)d_in[7]; p.hg_wo = (const float*)d_in[8];
    p.lnm_g = (const float*)d_in[9]; p.lnm_b = (const float*)d_in[10]; p.ffn_win = (const float*)d_in[11]; p.ffn_wout = (const float*)d_in[12];
    p.lnf_g = (const float*)d_in[13]; p.lnf_b = (const float*)d_in[14]; p.ple_wg = (const float*)d_in[15]; p.ple_wp = (const float*)d_in[16];
    p.out = (float*)d_out; p.ws = (unsigned char*)d_ws;
    void* args[] = {&p};
    hipError_t e = hipLaunchCooperativeKernel((const void*)mk_fwd, dim3(grid), dim3(512), args, LDS_BYTES, stream);
    if (e != hipSuccess) fprintf(stderr, "kernel_launch: cooperative launch failed: %s (grid %d)\n", hipGetErrorString(e), grid);
}
```

```cpp
#include <hip/hip_runtime.h>
#include <hip/hip_cooperative_groups.h>
#include <cstdio>
#include <cstdint>
namespace cg = cooperative_groups;
namespace pg8 {
#define PG8_LAS __attribute__((address_space(3)))
typedef unsigned short bf16_t;
typedef short bf16x8 __attribute__((ext_vector_type(8)));
typedef float f32x4 __attribute__((ext_vector_type(4)));
typedef unsigned u32x4 __attribute__((ext_vector_type(4)));
constexpr int BM = 256, BK = 64, HALF = 128, HTB = HALF * BK * 2  , STAGE_BYTES = 8 * HTB, NXCD = 8, WGM = 8;

__host__ __device__ __forceinline__ int lds_byte(int r, int c) { const int st = (r >> 4) * 2 + (c >> 5), rr = r & 15, cc = c & 31, ob = rr * 64 + cc * 2; return st * 1024 + (ob ^ (((ob >> 9) & 1) << 5)); }
__host__ __device__ __forceinline__ void stage_rc(int b, int& R, int& C) { const int st = b / 1024, sb = b % 1024, swz = sb ^ (((sb >> 9) & 1) << 5); R = (st >> 1) * 16 + swz / 64; C = (st & 1) * 32 + (swz % 64) / 2; }
__host__ __device__ __forceinline__ int perm32(int rho) { const int n = rho >> 4, i = rho & 15; return 8 * (i >> 2) + 4 * n + (i & 3); }

struct Unit { int pm, pn; };
struct Gemm { const bf16_t* A; const bf16_t* Bt; int M, N, K, lda, ldb; size_t ahs; };

struct StaticOrder {
    int nM, nN, nwg, G, c;
    __host__ __device__ void init(int M, int N, int G_, int c_) { nM = M / BM; nN = N / BM; nwg = nM * nN; G = G_; c = c_; }
    __host__ __device__ bool next(int i, Unit& u) const {
        const long L = (long)i * G + c; if (L >= nwg) return false;
        int wgid = (int)L; { const int q = nwg / NXCD, r = nwg % NXCD, xcd = wgid % NXCD, off = wgid / NXCD; wgid = (xcd < r ? xcd * (q + 1) : r * (q + 1) + (xcd - r) * q) + off; }
        const int nig = WGM * nN, gid = wgid / nig, fm = gid * WGM, gsz = (nM - fm) < WGM ? (nM - fm) : WGM;
        u.pm = fm + ((wgid % nig) % gsz); u.pn = (wgid % nig) / gsz; return true;
    }
    __device__ __forceinline__ void a_ready(const Unit&) const {}
    __device__ __forceinline__ void done(const Unit&) const {}
};

__device__ __forceinline__ unsigned cvt_pk_bf16(float lo, float hi) { unsigned r; asm volatile("v_cvt_pk_bf16_f32 %0, %1, %2" : "=v"(r) : "v"(lo), "v"(hi)); return r; }
template <class Epi, class Sched, bool ALIGN_EPI = false, bool SP2 = false>
__device__ __forceinline__ void gemm_phase(PG8_LAS unsigned char* lds, const Gemm g, const Sched& S, const Epi& E) {
    int tid_l = threadIdx.x; asm volatile("" : "+v"(tid_l));
    const int tid = tid_l, wid = __builtin_amdgcn_readfirstlane(tid >> 6), lane = tid & 63, wr = wid >> 2, wc = wid & 3, fr = lane & 15, fq = lane >> 4;
    const int K = g.K, nt = K / BK;
    unsigned voffA[2], voffB[2];
#pragma unroll
    for (int i = 0; i < 2; ++i) { int R, C; stage_rc(tid * 16 + i * 8192, R, C); const int Rb = Epi::PERM ? ((R & ~31) + perm32(R & 31)) : R;
        voffA[i] = (unsigned)(R * g.lda + C) * 2u; voffB[i] = (unsigned)(Rb * g.ldb + C) * 2u; }
    const size_t kstep = (size_t)(BK * 2);
#define PG8_AK(t_) (g.ahs ? (size_t)((t_) >> 1) * g.ahs + (size_t)((t_) & 1) * 128 : (size_t)(t_) * kstep)
    const size_t hstepA = (size_t)HALF * g.lda * 2, hstepB = (size_t)HALF * g.ldb * 2;
    const size_t tstepA = 2 * hstepA, tstepB = 2 * hstepB;
    const unsigned ldsw = (unsigned)wid * 1024u;
    const int aoff = lds_byte(wr * 64 + fr, fq * 8), boff = lds_byte(wc * 32 + fr, fq * 8);
#define PG8_SA(b, h) (((b) * 2 + (h)) * HTB)
#define PG8_SB(b, h) ((4 + (b) * 2 + (h)) * HTB)
#define PG8_STAGE(bufoff, gbase, voff) do { _Pragma("unroll") for (int _i = 0; _i < 2; ++_i) \
        __builtin_amdgcn_global_load_lds((const unsigned*)((const char*)(gbase) + (voff)[_i]), (PG8_LAS unsigned*)(lds + (bufoff) + ldsw + _i * 8192), 16, 0, 0); } while (0)
#define PG8_LDA(dst, b, h) do { _Pragma("unroll") for (int m = 0; m < 4; ++m) _Pragma("unroll") for (int k = 0; k < 2; ++k) dst[m][k] = *(const PG8_LAS bf16x8*)(lds + PG8_SA(b, h) + aoff + m * 2048 + k * 1024); } while (0)
#define PG8_LDB(dst, b, h) do { _Pragma("unroll") for (int n = 0; n < 2; ++n) _Pragma("unroll") for (int k = 0; k < 2; ++k) dst[n][k] = *(const PG8_LAS bf16x8*)(lds + PG8_SB(b, h) + boff + n * 2048 + k * 1024); } while (0)
#define PG8_MMA(ai, bj, At, Bt) do { __builtin_amdgcn_s_setprio(1); _Pragma("unroll") for (int m = 0; m < 4; ++m) _Pragma("unroll") for (int n = 0; n < 2; ++n) _Pragma("unroll") for (int k = 0; k < 2; ++k) \
        acc[ai][bj][m][n] = __builtin_amdgcn_mfma_f32_16x16x32_bf16(Bt[n][k], At[m][k], acc[ai][bj][m][n], 0, 0, 0); __builtin_amdgcn_s_setprio(0); } while (0)
#define PG8_WAIT_V(n) asm volatile("s_waitcnt vmcnt(" #n ")" ::: "memory")
#define PG8_WAIT_L(n) asm volatile("s_waitcnt lgkmcnt(" #n ")" ::: "memory")
#define PG8_BAR __builtin_amdgcn_s_barrier()
#define PG8_SCHED __builtin_amdgcn_sched_barrier(0)
    Unit cur, nxt; int ui = 0;
    if (!S.next(0, cur)) return;
    f32x4 acc[2][2][4][2];
#pragma unroll
    for (int a = 0; a < 2; ++a)
#pragma unroll
        for (int b = 0; b < 2; ++b)
#pragma unroll
            for (int m = 0; m < 4; ++m)
#pragma unroll
                for (int n = 0; n < 2; ++n) acc[a][b][m][n] = (f32x4){0.f, 0.f, 0.f, 0.f};
    bf16x8 At[4][2], B0[2][2], B1[2][2];
    const char* cA = (const char*)g.A + (size_t)cur.pm * tstepA; const char* cB = (const char*)g.Bt + (size_t)cur.pn * tstepB;
    S.a_ready(cur);
    if constexpr (SP2) {
        PG8_STAGE(PG8_SB(0, 0), cB, voffB); PG8_STAGE(PG8_SB(0, 1), cB + hstepB, voffB); PG8_STAGE(PG8_SA(0, 0), cA, voffA); PG8_STAGE(PG8_SA(0, 1), cA + hstepA, voffA);
        if (wr == 1) PG8_BAR;
        PG8_WAIT_V(2); PG8_BAR;
        PG8_STAGE(PG8_SB(1, 0), cB + kstep, voffB); PG8_STAGE(PG8_SA(1, 0), cA + PG8_AK(1), voffA); PG8_STAGE(PG8_SB(1, 1), cB + hstepB + kstep, voffB);
        PG8_WAIT_V(6); PG8_BAR;
    } else {
        PG8_STAGE(PG8_SB(0, 0), cB, voffB); PG8_STAGE(PG8_SA(0, 0), cA, voffA); PG8_STAGE(PG8_SB(0, 1), cB + hstepB, voffB); PG8_STAGE(PG8_SA(0, 1), cA + hstepA, voffA);
        if (wr == 1) PG8_BAR;
        PG8_WAIT_V(4); PG8_BAR;
        PG8_STAGE(PG8_SB(1, 0), cB + kstep, voffB); PG8_STAGE(PG8_SA(1, 0), cA + PG8_AK(1), voffA); PG8_STAGE(PG8_SB(1, 1), cB + hstepB + kstep, voffB);
        PG8_WAIT_V(6); PG8_BAR;
    }
    for (;;) {
        const bool has_next = S.next(ui + 1, nxt);
        const char* nA = has_next ? (const char*)g.A + (size_t)nxt.pm * tstepA : cA; const char* nB = has_next ? (const char*)g.Bt + (size_t)nxt.pn * tstepB : cB;
        for (int t = 0; t < nt; t += 2) {
            const bool last = (t == nt - 2);
            const char* a1 = cA + PG8_AK(t + 1);
            const char* a2 = last ? nA : cA + PG8_AK(t + 2); const char* b2 = last ? nB : cB + (size_t)(t + 2) * kstep;
            const char* a3 = last ? nA + PG8_AK(1) : cA + PG8_AK(t + 3); const char* b3 = b2 + kstep;
            if (last && has_next) S.a_ready(nxt);
            if constexpr (SP2) {
            PG8_LDB(B0, 0, 0); PG8_LDB(B1, 0, 1); PG8_SCHED; PG8_LDA(At, 0, 0); PG8_STAGE(PG8_SA(1, 1), a1 + hstepA, voffA);
            PG8_WAIT_V(8); PG8_WAIT_L(0); PG8_BAR; PG8_MMA(0, 0, At, B0); PG8_MMA(0, 1, At, B1); PG8_BAR; PG8_SCHED;
            PG8_LDA(At, 0, 1); PG8_STAGE(PG8_SB(0, 0), b2, voffB); PG8_STAGE(PG8_SB(0, 1), b2 + hstepB, voffB); PG8_STAGE(PG8_SA(0, 0), a2, voffA);
            PG8_WAIT_V(8); PG8_WAIT_L(0); PG8_BAR; PG8_MMA(1, 0, At, B0); PG8_MMA(1, 1, At, B1); PG8_BAR; PG8_SCHED;
            PG8_LDB(B0, 1, 0); PG8_LDB(B1, 1, 1); PG8_SCHED; PG8_LDA(At, 1, 0); PG8_STAGE(PG8_SA(0, 1), a2 + hstepA, voffA);
            PG8_WAIT_V(8); PG8_WAIT_L(0); PG8_BAR; PG8_MMA(0, 0, At, B0); PG8_MMA(0, 1, At, B1); PG8_BAR; PG8_SCHED;
            PG8_LDA(At, 1, 1); PG8_STAGE(PG8_SB(1, 0), b3, voffB); PG8_STAGE(PG8_SB(1, 1), b3 + hstepB, voffB); PG8_STAGE(PG8_SA(1, 0), a3, voffA);
            PG8_WAIT_V(8); PG8_WAIT_L(0); PG8_BAR; PG8_MMA(1, 0, At, B0); PG8_MMA(1, 1, At, B1); PG8_BAR; PG8_SCHED;
            } else {
            PG8_LDB(B0, 0, 0); PG8_SCHED; PG8_LDA(At, 0, 0); PG8_STAGE(PG8_SA(1, 1), a1 + hstepA, voffA);
            PG8_WAIT_L(8); PG8_BAR; PG8_WAIT_L(0); PG8_MMA(0, 0, At, B0); PG8_BAR; PG8_SCHED;
            PG8_LDB(B1, 0, 1); PG8_STAGE(PG8_SB(0, 0), b2, voffB);
            PG8_BAR; PG8_WAIT_L(0); PG8_MMA(0, 1, At, B1); PG8_BAR;
            PG8_LDA(At, 0, 1); PG8_STAGE(PG8_SA(0, 0), a2, voffA);
            PG8_BAR; PG8_WAIT_L(0); PG8_MMA(1, 0, At, B0); PG8_BAR; PG8_SCHED;
            PG8_STAGE(PG8_SB(0, 1), b2 + hstepB, voffB);
            PG8_WAIT_V(6); PG8_BAR; PG8_MMA(1, 1, At, B1); PG8_BAR;
            PG8_LDB(B0, 1, 0); PG8_SCHED; PG8_LDA(At, 1, 0); PG8_STAGE(PG8_SA(0, 1), a2 + hstepA, voffA);
            PG8_WAIT_L(8); PG8_BAR; PG8_WAIT_L(0); PG8_MMA(0, 0, At, B0); PG8_BAR; PG8_SCHED;
            PG8_LDB(B1, 1, 1); PG8_STAGE(PG8_SB(1, 0), b3, voffB);
            PG8_BAR; PG8_WAIT_L(0); PG8_MMA(0, 1, At, B1); PG8_BAR;
            PG8_LDA(At, 1, 1); PG8_STAGE(PG8_SA(1, 0), a3, voffA);
            PG8_BAR; PG8_WAIT_L(0); PG8_MMA(1, 0, At, B0); PG8_BAR; PG8_SCHED;
            PG8_STAGE(PG8_SB(1, 1), b3 + hstepB, voffB);
            PG8_WAIT_V(6); PG8_BAR; PG8_MMA(1, 1, At, B1); PG8_BAR;
            }
        }
        if constexpr (ALIGN_EPI) { if (wr == 0) PG8_BAR; }
        if constexpr (!Epi::AFTER_DRAIN) { E(acc, cur, wr, wc, fr, fq); S.done(cur); }
        if (!has_next) break;
#pragma unroll
        for (int a = 0; a < 2; ++a)
#pragma unroll
            for (int b = 0; b < 2; ++b)
#pragma unroll
                for (int m = 0; m < 4; ++m)
#pragma unroll
                    for (int n = 0; n < 2; ++n) acc[a][b][m][n] = (f32x4){0.f, 0.f, 0.f, 0.f};
        cur = nxt; cA = nA; cB = nB; ++ui;
        if constexpr (ALIGN_EPI) { if (wr == 1) PG8_BAR; }
    }
    PG8_WAIT_V(0);
    if constexpr (!ALIGN_EPI) { if (wr == 0) PG8_BAR; }
    PG8_BAR;
    if constexpr (Epi::AFTER_DRAIN) { E.fused(acc, cur, wr, wc, fr, fq, lds, wid, lane); S.done(cur); }
#undef PG8_SA
#undef PG8_SB
#undef PG8_STAGE
#undef PG8_LDA
#undef PG8_LDB
#undef PG8_MMA
#undef PG8_WAIT_V
#undef PG8_WAIT_L
#undef PG8_BAR
#undef PG8_SCHED
}
}

using pg8::bf16_t; using pg8::bf16x8; using pg8::f32x4; using pg8::u32x4; using pg8::Unit; using pg8::cvt_pk_bf16;
typedef unsigned u32x2 __attribute__((ext_vector_type(2)));
typedef float f32x2 __attribute__((ext_vector_type(2)));
typedef float f32x16 __attribute__((ext_vector_type(16)));

constexpr int BATCH = 2, SEQ = 16384, D = 1024, M = BATCH * SEQ, DFF = 2816, PLE = 256, DEPTH = 4;
constexpr int NQKV = 1536, HIN = 5120;
constexpr float ALPHA = 1.681792830507429f, LN_EPS = 1e-5f, LOG2E = 1.4426950408889634f;
constexpr size_t MiB = (size_t)1 << 20;
constexpr size_t WS_WIN = 0, WS_WOUT = 10 * MiB, WS_W1 = 12 * MiB, WS_W2 = 23 * MiB, WS_WG = 29 * MiB, WS_WP = 31 * MiB, WS_VEC = 31 * MiB + 512 * 1024;
constexpr size_t WS_ST1 = 32 * MiB, WS_ST2 = 36 * MiB, WS_XBX = 40 * MiB, WS_XBY = 104 * MiB, WS_PP = 168 * MiB;
constexpr size_t WS_Q = 248 * MiB, WS_K = 312 * MiB, WS_V = 328 * MiB, WS_O = 344 * MiB, WS_H = 248 * MiB;
constexpr size_t WS_Z = 104 * MiB, WS_SB = 424 * MiB,     WS_PB = 488 * MiB, WS_ROPE = 504 * MiB, WS_LB = 505 * MiB, WS_DEC = 506 * MiB, WS_CTL = 508 * MiB, WS_VECP = 509 * MiB, WS_END = 510 * MiB;
constexpr size_t CTL_ZERO_BYTES = 16384;
constexpr int LDS_BYTES = 147456;
#define X1(...) __VA_ARGS__
#define X2(...) __VA_ARGS__ __VA_ARGS__
#define REP_SYNC X1
#define REP_WCONV X1
#define REP_ATT X1
#define REP_H1 X1
#define X0(...)
#define REP_H3 X0
#define REP_F1 X1
#define REP_HIN X1

__device__ __forceinline__ float bf_lo(unsigned w) { return __uint_as_float(w << 16); }
__device__ __forceinline__ float bf_hi(unsigned w) { return __uint_as_float(w & 0xffff0000u); }
typedef float f32x2_cv __attribute__((ext_vector_type(2))); typedef __bf16 bf16x2_cv __attribute__((ext_vector_type(2)));
__device__ __forceinline__ unsigned cvt_pk_c(float lo, float hi) { const f32x2_cv v = {lo, hi}; const bf16x2_cv b = __builtin_convertvector(v, bf16x2_cv); return __builtin_bit_cast(unsigned, b); }
__device__ __forceinline__ unsigned f2bf(float f) { unsigned u = __float_as_uint(f); return (u + 0x7fffu + ((u >> 16) & 1u)) >> 16; }
__device__ __forceinline__ float sigmoidf_(float x) { return __builtin_amdgcn_rcpf(1.0f + __expf(-x)); }
__device__ __forceinline__ u32x4 pack8(const f32x4 a, const f32x4 b) { u32x4 w; w.x = cvt_pk_bf16(a[0], a[1]); w.y = cvt_pk_bf16(a[2], a[3]); w.z = cvt_pk_bf16(b[0], b[1]); w.w = cvt_pk_bf16(b[2], b[3]); return w; }

__device__ __forceinline__ void load_row_stats(const f32x2* part, int pm, int wr, int fr, int fq, float (&mu)[8], float (&rs)[8]) {
    float mye[2], rse[2];
#pragma unroll
    for (int e = 0; e < 2; ++e) {
        const int row = pm * 256 + (fq >> 1) * 128 + wr * 64 + (2 * (fq & 1) + e) * 16 + fr;
        const f32x4* p = (const f32x4*)(part + (size_t)row * 16);
        float s = 0.f, q = 0.f;
#pragma unroll
        for (int i = 0; i < 8; ++i) { const f32x4 v = p[i]; s += v[0] + v[2]; q += v[1] + v[3]; }
        const float mean = s * (1.0f / 1024.0f); float var = q * (1.0f / 1024.0f) - mean * mean; var = var > 0.f ? var : 0.f;
        mye[e] = mean; rse[e] = __builtin_amdgcn_rsqf(var + LN_EPS);
    }
#pragma unroll
    for (int ai = 0; ai < 2; ++ai)
#pragma unroll
        for (int m = 0; m < 4; ++m) { const int src = fr + 16 * (ai * 2 + (m >> 1)); mu[ai * 4 + m] = __shfl(mye[m & 1], src); rs[ai * 4 + m] = __shfl(rse[m & 1], src); }
}

__device__ __forceinline__ void load_row_stats2(const f32x2* part, int pm, int wr, int fr, int fq, float (&mye)[2], float (&rse)[2]) {
#pragma unroll
    for (int e = 0; e < 2; ++e) {
        const int row = pm * 256 + (fq >> 1) * 128 + wr * 64 + (2 * (fq & 1) + e) * 16 + fr;
        const f32x4* p = (const f32x4*)(part + (size_t)row * 16);
        float s = 0.f, q = 0.f;
#pragma unroll
        for (int i = 0; i < 8; ++i) { const f32x4 v = p[i]; s += v[0] + v[2]; q += v[1] + v[3]; }
        const float mean = s * (1.0f / 1024.0f); float var = q * (1.0f / 1024.0f) - mean * mean; var = var > 0.f ? var : 0.f;
        mye[e] = mean; rse[e] = __builtin_amdgcn_rsqf(var + LN_EPS);
    }
}
#define ROW_MU(ai, m) __shfl(mye[(m) & 1], fr + 16 * ((ai) * 2 + ((m) >> 1)))
#define ROW_RS(ai, m) __shfl(rse[(m) & 1], fr + 16 * ((ai) * 2 + ((m) >> 1)))

struct EpiPlain {
    static constexpr bool PERM = true, AFTER_DRAIN = false;
    bf16_t* O; int ldc;
    __device__ __forceinline__ void operator()(const f32x4 (&acc)[2][2][4][2], const Unit& u, int wr, int wc, int fr, int fq) const {
        const int row0 = u.pm * 256 + wr * 64 + fr, col0 = u.pn * 256 + wc * 32 + 8 * fq;
#pragma unroll
        for (int ai = 0; ai < 2; ++ai)
#pragma unroll
            for (int m = 0; m < 4; ++m) { bf16_t* rowp = O + (size_t)(row0 + ai * 128 + m * 16) * ldc + col0;
#pragma unroll
                for (int bj = 0; bj < 2; ++bj) *(u32x4*)(rowp + bj * 128) = pack8(acc[ai][bj][m][0], acc[ai][bj][m][1]); }
    }
};

struct EpiQKV {
    static constexpr bool PERM = true, AFTER_DRAIN = false;
    bf16_t *Q, *K, *V; const float* rope;
    __device__ __forceinline__ void operator()(const f32x4 (&acc)[2][2][4][2], const Unit& u, int wr, int wc, int fr, int fq) const {
        bf16_t* base; int ldc, colt; float sc;
        if (u.pn < 4) { base = Q; ldc = 1024; colt = u.pn * 256; sc = 0.125f * LOG2E; } else if (u.pn == 4) { base = K; ldc = 256; colt = 0; sc = 1.f; } else { base = V; ldc = 256; colt = 0; sc = 1.f; }
        const bool do_rope = (u.pn < 5) && ((wc & 1) == 0) && (fq < 2);
        const int col0 = colt + wc * 32 + 8 * fq;
#pragma unroll
        for (int ai = 0; ai < 2; ++ai)
#pragma unroll
            for (int m = 0; m < 4; ++m) {
                const int row = u.pm * 256 + ai * 128 + wr * 64 + m * 16 + fr, pos = row & (SEQ - 1);
                f32x4 c4 = {1.f, 1.f, 1.f, 1.f}, s4 = {0.f, 0.f, 0.f, 0.f};
                if (do_rope) { c4 = *(const f32x4*)(rope + (size_t)pos * 8 + 4 * fq); s4 = *(const f32x4*)(rope + (size_t)SEQ * 8 + (size_t)pos * 8 + 4 * fq); }
#pragma unroll
                for (int bj = 0; bj < 2; ++bj) {
                    f32x4 v0 = acc[ai][bj][m][0], v1 = acc[ai][bj][m][1];
                    if (do_rope) {
                        f32x4 r0, r1;
                        r0[0] = v0[0] * c4[0] - v0[1] * s4[0]; r0[1] = v0[1] * c4[0] + v0[0] * s4[0];
                        r0[2] = v0[2] * c4[1] - v0[3] * s4[1]; r0[3] = v0[3] * c4[1] + v0[2] * s4[1];
                        r1[0] = v1[0] * c4[2] - v1[1] * s4[2]; r1[1] = v1[1] * c4[2] + v1[0] * s4[2];
                        r1[2] = v1[2] * c4[3] - v1[3] * s4[3]; r1[3] = v1[3] * c4[3] + v1[2] * s4[3];
                        v0 = r0; v1 = r1;
                    }
                    v0 = v0 * sc; v1 = v1 * sc;
                    *(u32x4*)(base + (size_t)row * ldc + col0 + bj * 128) = pack8(v0, v1);
                }
            }
    }
};

struct EpiHin {
    static constexpr bool PERM = true, AFTER_DRAIN = false;
    bf16_t* Z; const float* lb;
    __device__ __forceinline__ void operator()(const f32x4 (&acc)[2][2][4][2], const Unit& u, int wr, int wc, int fr, int fq) const {
        const int seg = u.pn >> 2, col0 = u.pn * 256 + wc * 32 + 8 * fq;
#pragma unroll
        for (int bj = 0; bj < 2; ++bj) {
            f32x4 l0 = {0.f, 0.f, 0.f, 0.f}, l1 = l0;
            if (seg == 1 || seg == 2) { const float* lp = lb + (col0 + bj * 128 - 1024); l0 = *(const f32x4*)lp; l1 = *(const f32x4*)(lp + 4); }
#pragma unroll
            for (int ai = 0; ai < 2; ++ai)
#pragma unroll
                for (int m = 0; m < 4; ++m) {
                    const int row = u.pm * 256 + ai * 128 + wr * 64 + m * 16 + fr;
                    f32x4 v0 = acc[ai][bj][m][0], v1 = acc[ai][bj][m][1];
                    if (seg == 0 || seg == 4) {
#pragma unroll
                        for (int i = 0; i < 4; ++i) { v0[i] = v0[i] * sigmoidf_(v0[i]); v1[i] = v1[i] * sigmoidf_(v1[i]); }
                    } else if (seg == 1 || seg == 2) {
#pragma unroll
                        for (int i = 0; i < 4; ++i) { v0[i] = __builtin_amdgcn_logf(l0[i] + (1.f - l0[i]) * sigmoidf_(v0[i])); v1[i] = __builtin_amdgcn_logf(l1[i] + (1.f - l1[i]) * sigmoidf_(v1[i]));     }
                    }
                    *(u32x4*)(Z + ((size_t)(seg * 8 + 2 * (u.pn & 3) + bj) * M + row) * 128 + wc * 32 + 8 * fq) = pack8(v0, v1);
                }
        }
    }
};

__device__ __forceinline__ void split_hilo(const f32x4 y0, const f32x4 y1, u32x4& hi, u32x4& lo) {
    hi = pack8(y0, y1);
    const f32x4 h0 = {bf_lo(hi.x), bf_hi(hi.x), bf_lo(hi.y), bf_hi(hi.y)}, h1 = {bf_lo(hi.z), bf_hi(hi.z), bf_lo(hi.w), bf_hi(hi.w)};
    lo = pack8(y0 - h0, y1 - h1);
}
__device__ __forceinline__ void join_hilo(const u32x4 hi, const u32x4 lo, f32x4& y0, f32x4& y1) {
    y0 = (f32x4){bf_lo(hi.x) + bf_lo(lo.x), bf_hi(hi.x) + bf_hi(lo.x), bf_lo(hi.y) + bf_lo(lo.y), bf_hi(hi.y) + bf_hi(lo.y)};
    y1 = (f32x4){bf_lo(hi.z) + bf_lo(lo.z), bf_hi(hi.z) + bf_hi(lo.z), bf_lo(hi.w) + bf_lo(lo.w), bf_hi(hi.w) + bf_hi(lo.w)};
}
template <bool LNRES, bool F32IN> struct EpiRes {
    static constexpr bool PERM = true, AFTER_DRAIN = false;
    const float* resid; const bf16_t* rhi; const bf16_t* rlo; bf16_t* xb; bf16_t* wlo; f32x2* part_out; const f32x2* part_in; const float* g; const float* b;
    __device__ __forceinline__ void operator()(const f32x4 (&acc)[2][2][4][2], const Unit& u, int wr, int wc, int fr, int fq) const {
        float mye[2] = {0.f, 0.f}, rse[2] = {0.f, 0.f};
        if (LNRES) load_row_stats2(part_in, u.pm, wr, fr, fq, mye, rse);
        const int col0 = u.pn * 256 + wc * 32 + 8 * fq;
        const size_t tile_off = (size_t)(u.pm * 256 + wr * 64) * D + u.pn * 256 + wc * 32;
        const unsigned lane_off = (unsigned)fr * D + 8 * fq;
        float ss[8], qq[8];
#pragma unroll
        for (int i = 0; i < 8; ++i) { ss[i] = 0.f; qq[i] = 0.f; }
        constexpr int NB = LNRES ? 2 : 4;
#pragma unroll
        for (int bj = 0; bj < 2; ++bj) {
            f32x4 g0, g1, b0, b1;
            if (LNRES) { g0 = *(const f32x4*)(g + col0 + bj * 128); g1 = *(const f32x4*)(g + col0 + bj * 128 + 4); b0 = *(const f32x4*)(b + col0 + bj * 128); b1 = *(const f32x4*)(b + col0 + bj * 128 + 4); }
#pragma unroll
            for (int h0 = 0; h0 < 8; h0 += NB) {
                u32x4 rv[NB][2];
#pragma unroll
                for (int k = 0; k < NB; ++k) { const int idx = h0 + k, ai = idx >> 2, m = idx & 3; const unsigned off = lane_off + (unsigned)((ai * 128 + m * 16) * D + bj * 128);
                    if (F32IN) { rv[k][0] = *(const u32x4*)(resid + tile_off + off); rv[k][1] = *(const u32x4*)(resid + tile_off + off + 4); }
                    else { rv[k][0] = *(const u32x4*)(rhi + tile_off + off); rv[k][1] = *(const u32x4*)(rlo + tile_off + off); } }
#pragma unroll
                for (int k = 0; k < NB; ++k) { const int idx = h0 + k, ai = idx >> 2, m = idx & 3; const unsigned off = lane_off + (unsigned)((ai * 128 + m * 16) * D + bj * 128);
                    f32x4 r0, r1;
                    if (F32IN) { r0 = __builtin_bit_cast(f32x4, rv[k][0]); r1 = __builtin_bit_cast(f32x4, rv[k][1]); } else join_hilo(rv[k][0], rv[k][1], r0, r1);
                    if (LNRES) { const float mm = ROW_MU(ai, m), rr = ROW_RS(ai, m); r0 = (r0 - mm) * rr * g0 + b0; r1 = (r1 - mm) * rr * g1 + b1; }
                    const f32x4 y0 = r0 * ALPHA + acc[ai][bj][m][0], y1 = r1 * ALPHA + acc[ai][bj][m][1];
                    u32x4 hi, lo; split_hilo(y0, y1, hi, lo);
                    *(u32x4*)(xb + tile_off + off) = hi; *(u32x4*)(wlo + tile_off + off) = lo;
                    ss[idx] += (y0[0] + y0[1]) + (y0[2] + y0[3]) + (y1[0] + y1[1]) + (y1[2] + y1[3]);
                    qq[idx] += (y0[0] * y0[0] + y0[1] * y0[1]) + (y0[2] * y0[2] + y0[3] * y0[3]) + (y1[0] * y1[0] + y1[1] * y1[1]) + (y1[2] * y1[2] + y1[3] * y1[3]);
                }
            }
        }
#pragma unroll
        for (int ai = 0; ai < 2; ++ai)
#pragma unroll
            for (int m = 0; m < 4; ++m) {
                float s = ss[ai * 4 + m], q = qq[ai * 4 + m];
                s += __shfl_xor(s, 16); s += __shfl_xor(s, 32); q += __shfl_xor(q, 16); q += __shfl_xor(q, 32);
                const int row = u.pm * 256 + ai * 128 + wr * 64 + m * 16 + fr;
                if (fq == 0) part_out[(size_t)row * 16 + u.pn * 4 + wc] = (f32x2){s, q};
            }
    }
};

struct EpiFfn1 {
    static constexpr bool PERM = true, AFTER_DRAIN = false;
    bf16_t* H; const f32x2* part; const float* cs; const float* bw;
    __device__ __forceinline__ void operator()(const f32x4 (&acc)[2][2][4][2], const Unit& u, int wr, int wc, int fr, int fq) const {
        float mu[8], rs[8];
        load_row_stats(part, u.pm, wr, fr, fq, mu, rs);
        const int col0 = u.pn * 256 + wc * 32 + 8 * fq, hcol0 = u.pn * 128 + wc * 16 + 4 * fq;
#pragma unroll
        for (int bj = 0; bj < 2; ++bj) {
            const f32x4 c0 = *(const f32x4*)(cs + col0 + bj * 128), c1 = *(const f32x4*)(cs + col0 + bj * 128 + 4), w0 = *(const f32x4*)(bw + col0 + bj * 128), w1 = *(const f32x4*)(bw + col0 + bj * 128 + 4);
#pragma unroll
            for (int ai = 0; ai < 2; ++ai)
#pragma unroll
                for (int m = 0; m < 4; ++m) {
                    const int row = u.pm * 256 + ai * 128 + wr * 64 + m * 16 + fr; const float mm = mu[ai * 4 + m], rr = rs[ai * 4 + m];
                    const f32x4 v0 = (acc[ai][bj][m][0] - c0 * mm) * rr + w0, v1 = (acc[ai][bj][m][1] - c1 * mm) * rr + w1;
                    const float h0 = v0[0] * sigmoidf_(v0[0]) * v0[1], h1 = v0[2] * sigmoidf_(v0[2]) * v0[3], h2 = v1[0] * sigmoidf_(v1[0]) * v1[1], h3 = v1[2] * sigmoidf_(v1[2]) * v1[3];
                    u32x2 w; w.x = cvt_pk_bf16(h0, h1); w.y = cvt_pk_bf16(h2, h3);
                    *(u32x2*)(H + (size_t)row * DFF + hcol0 + bj * 64) = w;
                }
        }
    }
};

template <bool LAST> struct EpiPle {
    static constexpr bool PERM = true, AFTER_DRAIN = false;
    float* out; const bf16_t* yhi; const bf16_t* ylo; bf16_t* xb; bf16_t* wlo; const f32x2* part; const float *g, *b, *cs, *bw; const bf16_t* pp;
    __device__ __forceinline__ void operator()(const f32x4 (&acc)[2][2][4][2], const Unit& u, int wr, int wc, int fr, int fq) const {
        float mye[2], rse[2];
        load_row_stats2(part, u.pm, wr, fr, fq, mye, rse);
        const int col0 = u.pn * 256 + wc * 32 + 8 * fq;
        const size_t tile_off = (size_t)(u.pm * 256 + wr * 64) * D + u.pn * 256 + wc * 32;
        const unsigned lane_off = (unsigned)fr * D + 8 * fq;
#pragma unroll
        for (int bj = 0; bj < 2; ++bj) {
            const int cc = col0 + bj * 128;
            const f32x4 g0 = *(const f32x4*)(g + cc), g1 = *(const f32x4*)(g + cc + 4), b0 = *(const f32x4*)(b + cc), b1 = *(const f32x4*)(b + cc + 4);
            const f32x4 c0 = *(const f32x4*)(cs + cc), c1 = *(const f32x4*)(cs + cc + 4), w0 = *(const f32x4*)(bw + cc), w1 = *(const f32x4*)(bw + cc + 4);
#pragma unroll
            for (int am = 0; am < 8; am += 2) { const int ai = am >> 2;
                u32x4 yv[4][2]; u32x4 pv[4];
#pragma unroll
                for (int m = (am & 3); m < (am & 3) + 2; ++m) { const unsigned off = lane_off + (unsigned)((ai * 128 + m * 16) * D + bj * 128);
                    yv[m][0] = *(const u32x4*)(yhi + tile_off + off); yv[m][1] = *(const u32x4*)(ylo + tile_off + off); pv[m] = *(const u32x4*)(pp + tile_off + off); }
#pragma unroll
                for (int m = (am & 3); m < (am & 3) + 2; ++m) {
                    const unsigned off = lane_off + (unsigned)((ai * 128 + m * 16) * D + bj * 128); const float mm = ROW_MU(ai, m), rr = ROW_RS(ai, m);
                    f32x4 y0, y1; join_hilo(yv[m][0], yv[m][1], y0, y1); const u32x4 pw = pv[m];
                    const f32x4 p0 = {bf_lo(pw.x), bf_hi(pw.x), bf_lo(pw.y), bf_hi(pw.y)}, p1 = {bf_lo(pw.z), bf_hi(pw.z), bf_lo(pw.w), bf_hi(pw.w)};
                    f32x4 t0 = (acc[ai][bj][m][0] - c0 * mm) * rr + w0, t1 = (acc[ai][bj][m][1] - c1 * mm) * rr + w1;
#pragma unroll
                    for (int i = 0; i < 4; ++i) { t0[i] = sigmoidf_(t0[i]); t1[i] = sigmoidf_(t1[i]); }
                    const f32x4 x0 = (y0 - mm) * rr * g0 + b0 + t0 * p0, x1 = (y1 - mm) * rr * g1 + b1 + t1 * p1;
                    if (LAST) { *(f32x4*)(out + tile_off + off) = x0; *(f32x4*)(out + tile_off + off + 4) = x1; }
                    else { u32x4 hi, lo; split_hilo(x0, x1, hi, lo); *(u32x4*)(xb + tile_off + off) = hi; *(u32x4*)(wlo + tile_off + off) = lo; }
                }
            }
        }
    }
};

template <int MODE, bool FOLD>
__device__ __forceinline__ void conv_item(const float* W, int K, int N, bf16_t* Bt, int n0, int k0, int klen, const float* g, const float* bvec, float* cs, float* bw, float* scr, int lane) {
    const int np = n0 + (lane & 31); int src = np;
    if (MODE == 1) { if (np < 1280) { const int hp = np & 63; if (hp < 16) src = (np & ~63) + (hp >> 1) + 8 * (hp & 1); } }
    if (MODE == 2) { const int t = np >> 8, w = np & 255; src = (w & 1) * DFF + t * 128 + (w >> 1); }
    float csacc = 0.f, bacc = 0.f;
    for (int ks = k0; ks < k0 + klen; ks += 64) {
#pragma unroll 8
        for (int i = 0; i < 32; ++i) {
            const int kk = 2 * i + (lane >> 5);
            float w = W[(size_t)(ks + kk) * N + src];
            if (FOLD) { bacc += bvec[ks + kk] * w; w *= g[ks + kk]; }
            const float r = __uint_as_float(cvt_pk_c(w, 0.f) << 16);
            if (FOLD) csacc += r;
            scr[kk * 33 + (lane & 31)] = r;
        }
        asm volatile("s_waitcnt lgkmcnt(0)" ::: "memory");
        const int c = lane & 7;
#pragma unroll
        for (int j = 0; j < 4; ++j) {
            const int n = (lane >> 3) + 8 * j; const float* s = scr + (8 * c) * 33 + n;
            u32x4 o; o.x = cvt_pk_bf16(s[0 * 33], s[1 * 33]); o.y = cvt_pk_bf16(s[2 * 33], s[3 * 33]); o.z = cvt_pk_bf16(s[4 * 33], s[5 * 33]); o.w = cvt_pk_bf16(s[6 * 33], s[7 * 33]);
            *(u32x4*)(Bt + (size_t)(n0 + n) * K + ks + 8 * c) = o;
        }
        asm volatile("s_waitcnt lgkmcnt(0)" ::: "memory");
    }
    if (FOLD) {
        csacc += __shfl_xor(csacc, 32); bacc += __shfl_xor(bacc, 32);
        if (lane < 32) { cs[np] = csacc; bw[np] = bacc; }
    }
}

__device__ __forceinline__ void cvt_f32_bf16(const float* src, bf16_t* dst, size_t n, size_t gt, size_t GT) {
    for (size_t i = gt * 8; i < n; i += GT * 8) { const f32x4 a = *(const f32x4*)(src + i), b = *(const f32x4*)(src + i + 4); *(u32x4*)(dst + i) = pack8(a, b); }
}

__device__ __forceinline__ void vec_finalize(unsigned char* ws, int G, int blk) {
    const float* vecp = (const float*)(ws + WS_VECP); float* vec = (float*)(ws + WS_VEC);
    for (int i = blk * 512 + threadIdx.x; i < 13312; i += G * 512) { float a = 0.f;
#pragma unroll
        for (int kb = 0; kb < 16; ++kb) a += vecp[(size_t)kb * 13312 + i];
        vec[i] = a; }
}
struct Ptrs {
    const float *x, *p, *att_wqkv, *att_sink, *att_wo, *hg_win, *hg_lb, *hg_ng, *hg_wo, *lnm_g, *lnm_b, *ffn_win, *ffn_wout, *lnf_g, *lnf_b, *ple_wg, *ple_wp;
    float* out; unsigned char* ws;
};

typedef const Ptrs __attribute__((address_space(4)))* KP;
__device__ __forceinline__ void wconv_phase(KP Pk, int L, unsigned char* lds, int G, int blk) {
#define P (*Pk)
    int tid_l = threadIdx.x; asm volatile("" : "+v"(tid_l)); const int tid = tid_l, lane = tid & 63, wid = __builtin_amdgcn_readfirstlane(tid >> 6), j = L >> 1; const bool att = (L & 1) == 0;
    float* scr = (float*)(lds + wid * 16384);
    unsigned char* ws = P.ws;
    bf16_t *WIN = (bf16_t*)(ws + WS_WIN), *WOUT = (bf16_t*)(ws + WS_WOUT), *W1 = (bf16_t*)(ws + WS_W1), *W2 = (bf16_t*)(ws + WS_W2), *WG = (bf16_t*)(ws + WS_WG), *WP = (bf16_t*)(ws + WS_WP);
    float* vecp = (float*)(ws + WS_VECP);
    const int nin = att ? NQKV / 32 : HIN / 32;
    const int I0 = nin * 16, I1 = I0 + 32 * 16, I2 = I1 + 176 * 16, I3 = I2 + 32 * 44, I4 = I3 + 32 * 16, I5 = I4 + 32 * 4;
    for (int it = wid * G + blk; it < I5; it += 8 * G) {
        if (it < I0) { const int nb = it >> 4, kb = it & 15; if (att) conv_item<1, false>(P.att_wqkv + (size_t)j * D * NQKV, D, NQKV, WIN, nb * 32, kb * 64, 64, nullptr, nullptr, nullptr, nullptr, scr, lane);
                       else conv_item<0, false>(P.hg_win + (size_t)j * D * HIN, D, HIN, WIN, nb * 32, kb * 64, 64, nullptr, nullptr, nullptr, nullptr, scr, lane); }
        else if (it < I1) { const int r = it - I0, nb = r >> 4, kb = r & 15; conv_item<0, false>((att ? P.att_wo : P.hg_wo) + (size_t)j * D * D, D, D, WOUT, nb * 32, kb * 64, 64, nullptr, nullptr, nullptr, nullptr, scr, lane); }
        else if (it < I2) { const int r = it - I1, nb = r >> 4, kb = r & 15; float* vp = vecp + (size_t)kb * 13312; conv_item<2, true>(P.ffn_win + (size_t)L * D * 2 * DFF, D, 2 * DFF, W1, nb * 32, kb * 64, 64, P.lnm_g + L * D, P.lnm_b + L * D, vp, vp + 5632, scr, lane); }
        else if (it < I3) { const int r = it - I2, nb = r / 44, kb = r % 44; conv_item<0, false>(P.ffn_wout + (size_t)L * DFF * D, DFF, D, W2, nb * 32, kb * 64, 64, nullptr, nullptr, nullptr, nullptr, scr, lane); }
        else if (it < I4) { const int r = it - I3, nb = r >> 4, kb = r & 15; float* vp = vecp + (size_t)kb * 13312; conv_item<0, true>(P.ple_wg + (size_t)L * D * D, D, D, WG, nb * 32, kb * 64, 64, P.lnf_g + L * D, P.lnf_b + L * D, vp + 11264, vp + 12288, scr, lane); }
        else { const int r = it - I4, nb = r >> 2, kb = r & 3; conv_item<0, false>(P.ple_wp + (size_t)L * PLE * D, PLE, D, WP, nb * 32, kb * 64, 64, nullptr, nullptr, nullptr, nullptr, scr, lane); }
    }
    const size_t gt = (size_t)blk * 512 + tid, GT = (size_t)G * 512;
    cvt_f32_bf16(P.p + (size_t)L * M * PLE, (bf16_t*)(ws + WS_PB), (size_t)M * PLE, gt, GT);
    if (L == 0) {
        cvt_f32_bf16(P.x, (bf16_t*)(ws + WS_XBX), (size_t)M * D, gt, GT);
        float* rope = (float*)(ws + WS_ROPE);
        for (size_t i = gt; i < (size_t)SEQ * 8; i += GT) {
            const int pos = (int)(i >> 3), fi = (int)(i & 7);
            const float invs[8] = {1.0f, 0x1.8d275ep-3f, 0x1.34119p-5f, 0x1.ddee9cp-8f, 0x1.72ba44p-10f, 0x1.1f91fp-12f, 0x1.be218ap-15f, 0x1.5a0f5p-17f};
            float inv = invs[0];
#pragma unroll
            for (int q = 1; q < 8; ++q) inv = (fi == q) ? invs[q] : inv;
            const float ang = (float)pos * inv;
            const double rev = (double)ang * 0.15915494309189535; const double fr = rev - __builtin_rint(rev);
            const float x = (float)fr;
            rope[i] = __builtin_amdgcn_cosf(x); rope[(size_t)SEQ * 8 + i] = __builtin_amdgcn_sinf(x);
        }
    }
    if (!att) {
        float* lb = (float*)(ws + WS_LB);
        for (size_t i = gt; i < 2048; i += GT) {
            float v[4], mx = -1e30f;
#pragma unroll
            for (int d = 0; d < 4; ++d) { v[d] = P.hg_lb[(size_t)d * 2048 + i]; mx = fmaxf(mx, v[d]); }
            float den = 0.f, num = 0.f;
#pragma unroll
            for (int d = 0; d < 4; ++d) { const float e = __expf(v[d] - mx); den += e; if (d >= 1 && d <= L) num += e; }
            lb[i] = num / den;
        }
    }
#undef P
}

__device__ __forceinline__ int crow(int r, int hi) { return (r & 3) + 8 * (r >> 2) + 4 * hi; }
__device__ __forceinline__ void attn_phase(unsigned char* lds, const bf16_t* Q, const bf16_t* Kb, const bf16_t* Vb, bf16_t* O, const float* sink, int G, int blk) {
    int tid_l = threadIdx.x; asm volatile("" : "+v"(tid_l)); const int tid = tid_l, lane = tid & 63, wid = __builtin_amdgcn_readfirstlane(tid >> 6), r32 = lane & 31, hi = lane >> 5;
    bf16_t* Ks = (bf16_t*)lds; bf16_t* Vt = (bf16_t*)(lds + 384 * 72 * 2);
    for (int unit = blk; unit < 1024; unit += G) {
        const int b = unit >> 9, kvh = (unit >> 7) & 3, qb = unit & 127, start = qb * 128;
        asm volatile("s_waitcnt lgkmcnt(0)\n\ts_barrier" ::: "memory");
        for (int idx = tid; idx < 384 * 8; idx += 512) {
            const int key = idx >> 3, ch = idx & 7, kpos = start - 128 + key;
            if (kpos >= 0 && kpos < SEQ) {
                const size_t gofs = ((size_t)(b * SEQ + kpos)) * 256 + kvh * 64 + ch * 8;
                const u32x4 kv = *(const u32x4*)(Kb + gofs); *(u32x4*)(Ks + key * 72 + ch * 8) = kv;
                const u32x4 vv = *(const u32x4*)(Vb + gofs);
#pragma unroll
                for (int jj = 0; jj < 4; ++jj) { const unsigned w = vv[jj]; Vt[(ch * 8 + 2 * jj) * 392 + key] = (bf16_t)(w & 0xffffu); Vt[(ch * 8 + 2 * jj + 1) * 392 + key] = (bf16_t)(w >> 16); }
            }
        }
        __syncthreads();
        const int g = wid >> 1, half = wid & 1, head = kvh * 4 + g;
        const float sk = sink[head] * LOG2E;
        for (int sb = 0; sb < 2; ++sb) {
            const int r0 = 64 * half + 32 * sb; const size_t tok = (size_t)b * SEQ + start + r0 + r32;
            bf16x8 qf[4];
#pragma unroll
            for (int ks = 0; ks < 4; ++ks) qf[ks] = *(const bf16x8*)(Q + tok * 1024 + head * 64 + 16 * ks + 8 * hi);
            float m = sk, l = 1.f; f32x16 o0 = {}, o1 = {};
            const int base_pos = start - 128 + r0;
            const int jlo = base_pos < 0 ? ((-base_pos + 31) >> 5) : 0, jhi = (SEQ - base_pos) >= 288 ? 9 : ((SEQ - base_pos) >> 5);
            bf16x8 kc[4];
#pragma unroll
            for (int ks = 0; ks < 4; ++ks) kc[ks] = *(const bf16x8*)(Ks + (r0 + 32 * jlo + r32) * 72 + 16 * ks + 8 * hi);
            for (int j = jlo; j < jhi; ++j) {
                const int key0 = r0 + 32 * j;
                bf16x8 kn[4];
                const int keyn = (j + 1 < jhi) ? key0 + 32 : key0;
#pragma unroll
                for (int ks = 0; ks < 4; ++ks) kn[ks] = *(const bf16x8*)(Ks + (keyn + r32) * 72 + 16 * ks + 8 * hi);
                u32x2 va[2][4];
#pragma unroll
                for (int s2 = 0; s2 < 2; ++s2) { const bf16_t* v0 = Vt + r32 * 392 + key0 + 16 * s2 + 4 * hi;
                    va[s2][0] = *(const u32x2*)v0; va[s2][1] = *(const u32x2*)(v0 + 8); va[s2][2] = *(const u32x2*)(v0 + 32 * 392); va[s2][3] = *(const u32x2*)(v0 + 32 * 392 + 8); }
                __builtin_amdgcn_sched_barrier(0);
                f32x16 s = {};
#pragma unroll
                for (int ks = 0; ks < 4; ++ks) s = __builtin_amdgcn_mfma_f32_32x32x16_bf16(kc[ks], qf[ks], s, 0, 0, 0);
                if (j == 0) {
#pragma unroll
                    for (int r = 0; r < 16; ++r) if (crow(r, hi) < r32) s[r] = -INFINITY;
                }
                if (j == 8) {
#pragma unroll
                    for (int r = 0; r < 16; ++r) if (crow(r, hi) > r32) s[r] = -INFINITY;
                }
                float mx = s[0];
#pragma unroll
                for (int r = 1; r < 16; ++r) mx = fmaxf(mx, s[r]);
                mx = fmaxf(mx, __shfl_xor(mx, 32));
                const float mn = fmaxf(m, mx), al = __builtin_amdgcn_exp2f(m - mn);
                float rsum = 0.f;
#pragma unroll
                for (int r = 0; r < 16; ++r) { s[r] = __builtin_amdgcn_exp2f(s[r] - mn); rsum += s[r]; }
                rsum += __shfl_xor(rsum, 32);
                l = l * al + rsum; m = mn;
#pragma unroll
                for (int r = 0; r < 16; ++r) { o0[r] *= al; o1[r] *= al; }
                bf16x8 pf[2];
#pragma unroll
                for (int s2 = 0; s2 < 2; ++s2) { u32x4 w; w.x = cvt_pk_bf16(s[8 * s2 + 0], s[8 * s2 + 1]); w.y = cvt_pk_bf16(s[8 * s2 + 2], s[8 * s2 + 3]); w.z = cvt_pk_bf16(s[8 * s2 + 4], s[8 * s2 + 5]); w.w = cvt_pk_bf16(s[8 * s2 + 6], s[8 * s2 + 7]); pf[s2] = __builtin_bit_cast(bf16x8, w); }
#pragma unroll
                for (int s2 = 0; s2 < 2; ++s2) {
                    const u32x4 A0 = {va[s2][0].x, va[s2][0].y, va[s2][1].x, va[s2][1].y}, A1 = {va[s2][2].x, va[s2][2].y, va[s2][3].x, va[s2][3].y};
                    o0 = __builtin_amdgcn_mfma_f32_32x32x16_bf16(__builtin_bit_cast(bf16x8, A0), pf[s2], o0, 0, 0, 0);
                    o1 = __builtin_amdgcn_mfma_f32_32x32x16_bf16(__builtin_bit_cast(bf16x8, A1), pf[s2], o1, 0, 0, 0);
                }
#pragma unroll
                for (int ks = 0; ks < 4; ++ks) kc[ks] = kn[ks];
            }
            const float inv = 1.0f / l;
            bf16_t* op = O + tok * 1024 + head * 64 + 4 * hi;
#pragma unroll
            for (int g4 = 0; g4 < 4; ++g4) {
                u32x2 w0, w1;
                w0.x = cvt_pk_bf16(o0[4 * g4] * inv, o0[4 * g4 + 1] * inv); w0.y = cvt_pk_bf16(o0[4 * g4 + 2] * inv, o0[4 * g4 + 3] * inv);
                w1.x = cvt_pk_bf16(o1[4 * g4] * inv, o1[4 * g4 + 1] * inv); w1.y = cvt_pk_bf16(o1[4 * g4 + 2] * inv, o1[4 * g4 + 3] * inv);
                *(u32x2*)(op + 8 * g4) = w0; *(u32x2*)(op + 32 + 8 * g4) = w1;
            }
        }
    }
    __syncthreads();
}

constexpr size_t ZSEG = (size_t)8 * M * 128;
constexpr int HP = 136;
constexpr int L_TOT = 0, L_TOTE = 4096, L_KO = 8192, L_ST = L_KO + 128 * HP * 2, L_VT = L_ST + 128 * HP * 2, L_P = L_VT + 128 * HP * 2;
static_assert(L_P + 8 * 16 * HP * 2 - 16 <= LDS_BYTES - 16, "hgrn lds (the last 16 bytes are row padding, never touched: the grid barrier words live there)");
#define SCAN_STEP(ctrl, sh) asm volatile("s_nop 1\n\t" \
    "v_add_f32_dpp %0, %0, %0 " ctrl #sh " row_mask:0xf bank_mask:0xf bound_ctrl:1\n\tv_add_f32_dpp %1, %1, %1 " ctrl #sh " row_mask:0xf bank_mask:0xf bound_ctrl:1\n\t" \
    "v_add_f32_dpp %2, %2, %2 " ctrl #sh " row_mask:0xf bank_mask:0xf bound_ctrl:1\n\tv_add_f32_dpp %3, %3, %3 " ctrl #sh " row_mask:0xf bank_mask:0xf bound_ctrl:1\n\t" \
    "v_add_f32_dpp %4, %4, %4 " ctrl #sh " row_mask:0xf bank_mask:0xf bound_ctrl:1\n\tv_add_f32_dpp %5, %5, %5 " ctrl #sh " row_mask:0xf bank_mask:0xf bound_ctrl:1\n\t" \
    "v_add_f32_dpp %6, %6, %6 " ctrl #sh " row_mask:0xf bank_mask:0xf bound_ctrl:1\n\tv_add_f32_dpp %7, %7, %7 " ctrl #sh " row_mask:0xf bank_mask:0xf bound_ctrl:1" \
    : "+v"(v[0]), "+v"(v[1]), "+v"(v[2]), "+v"(v[3]), "+v"(v[4]), "+v"(v[5]), "+v"(v[6]), "+v"(v[7]))
template <int DIR> __device__ __forceinline__ void scan16x8(float* v) {
    if (DIR == 0) { SCAN_STEP("row_shr:", 1); SCAN_STEP("row_shr:", 2); SCAN_STEP("row_shr:", 4); SCAN_STEP("row_shr:", 8); }
    else          { SCAN_STEP("row_shl:", 1); SCAN_STEP("row_shl:", 2); SCAN_STEP("row_shl:", 4); SCAN_STEP("row_shl:", 8); }
}
__device__ __forceinline__ void load32(const bf16_t* p, float (&v)[32]) {
#pragma unroll
    for (int ks = 0; ks < 4; ++ks) { const u32x4 w = *(const u32x4*)(p + 32 * ks);
        v[8 * ks + 0] = bf_lo(w.x); v[8 * ks + 1] = bf_hi(w.x); v[8 * ks + 2] = bf_lo(w.y); v[8 * ks + 3] = bf_hi(w.y); v[8 * ks + 4] = bf_lo(w.z); v[8 * ks + 5] = bf_hi(w.z); v[8 * ks + 6] = bf_lo(w.w); v[8 * ks + 7] = bf_hi(w.w); }
}
__device__ __forceinline__ bf16x8 pk8(const float* v) { u32x4 w; w.x = cvt_pk_bf16(v[0], v[1]); w.y = cvt_pk_bf16(v[2], v[3]); w.z = cvt_pk_bf16(v[4], v[5]); w.w = cvt_pk_bf16(v[6], v[7]); return __builtin_bit_cast(bf16x8, w); }
#define WAVE_LDS_FENCE() do { asm volatile("s_waitcnt lgkmcnt(0)" ::: "memory"); __builtin_amdgcn_wave_barrier(); } while (0)

template <int DIR> __device__ __forceinline__ void h1_dir(unsigned char* lds, const bf16_t* zrow, int h, bf16_t* slot, float* decp) {
    int tid_l = threadIdx.x; asm volatile("" : "+v"(tid_l)); const int tid = tid_l, lane = tid & 63, wid = __builtin_amdgcn_readfirstlane(tid >> 6), r = lane & 15, kq = lane >> 4;
    float* TOT = (float*)(lds + L_TOT); bf16_t* KS = (bf16_t*)(lds + L_KO); bf16_t* VT = (bf16_t*)(lds + L_VT); bf16_t* STG = (bf16_t*)(lds + L_ST);
    float bl[32], kk[32];
    load32(zrow + (size_t)(1 + DIR) * ZSEG + 8 * kq, bl);
#pragma unroll
    for (int i = 0; i < 32; ++i) kk[i] = 1.0f - __builtin_amdgcn_exp2f(bl[i]);
        scan16x8<DIR>(bl); scan16x8<DIR>(bl + 8); scan16x8<DIR>(bl + 16); scan16x8<DIR>(bl + 24);
    if (r == (DIR ? 0 : 15)) {
#pragma unroll
        for (int ks = 0; ks < 4; ++ks) { *(f32x4*)(TOT + wid * 128 + 32 * ks + 8 * kq) = (f32x4){bl[8 * ks], bl[8 * ks + 1], bl[8 * ks + 2], bl[8 * ks + 3]}; *(f32x4*)(TOT + wid * 128 + 32 * ks + 8 * kq + 4) = (f32x4){bl[8 * ks + 4], bl[8 * ks + 5], bl[8 * ks + 6], bl[8 * ks + 7]}; }
    }
    __syncthreads();
    {
        float aft[32];
#pragma unroll
        for (int i = 0; i < 32; ++i) aft[i] = 0.f;
        for (int m = 0; m < 8; ++m) {
            const bool use = DIR ? (m <= wid) : (m >= wid);
            if (use) {
#pragma unroll
                for (int ks = 0; ks < 4; ++ks) { const f32x4 a = *(const f32x4*)(TOT + m * 128 + 32 * ks + 8 * kq), b = *(const f32x4*)(TOT + m * 128 + 32 * ks + 8 * kq + 4);
                    aft[8 * ks] += a[0]; aft[8 * ks + 1] += a[1]; aft[8 * ks + 2] += a[2]; aft[8 * ks + 3] += a[3]; aft[8 * ks + 4] += b[0]; aft[8 * ks + 5] += b[1]; aft[8 * ks + 6] += b[2]; aft[8 * ks + 7] += b[3]; }
            }
        }
        if (wid == (DIR ? 7 : 0) && r == 0) {
#pragma unroll
            for (int ks = 0; ks < 4; ++ks)
#pragma unroll
                for (int e = 0; e < 8; ++e) decp[32 * ks + 8 * kq + e] = __builtin_amdgcn_exp2f(aft[8 * ks + e]);
        }
#pragma unroll
        for (int ks = 0; ks < 4; ++ks)
#pragma unroll
            for (int e = 0; e < 8; e += 2) { const unsigned w = cvt_pk_c(kk[8 * ks + e] * __builtin_amdgcn_exp2f(aft[8 * ks + e] - bl[8 * ks + e]), kk[8 * ks + e + 1] * __builtin_amdgcn_exp2f(aft[8 * ks + e + 1] - bl[8 * ks + e + 1]));
                KS[(32 * ks + 8 * kq + e) * HP + 16 * wid + r] = (bf16_t)(w & 0xffffu); KS[(32 * ks + 8 * kq + e + 1) * HP + 16 * wid + r] = (bf16_t)(w >> 16); }
    }
    __syncthreads();
    f32x4 acc[8];
#pragma unroll
    for (int nt = 0; nt < 8; ++nt) acc[nt] = (f32x4){0.f, 0.f, 0.f, 0.f};
#pragma unroll
    for (int ks = 0; ks < 4; ++ks) {
        const bf16x8 a = *(const bf16x8*)(VT + (16 * wid + r) * HP + 32 * ks + 8 * kq);
#pragma unroll
        for (int nt = 0; nt < 8; ++nt) { const bf16x8 bb = *(const bf16x8*)(KS + (16 * nt + r) * HP + 32 * ks + 8 * kq); acc[nt] = __builtin_amdgcn_mfma_f32_16x16x32_bf16(a, bb, acc[nt], 0, 0, 0); }
    }
#pragma unroll
    for (int nt = 0; nt < 8; ++nt)
#pragma unroll
        for (int i = 0; i < 4; i += 2) { const unsigned w = cvt_pk_c(acc[nt][i], acc[nt][i + 1]); STG[(16 * wid + 4 * kq + i) * HP + 16 * nt + r] = (bf16_t)(w & 0xffffu); STG[(16 * wid + 4 * kq + i + 1) * HP + 16 * nt + r] = (bf16_t)(w >> 16); }
    WAVE_LDS_FENCE();
#pragma unroll
    for (int it = 0; it < 4; ++it) { const int p = lane + 64 * it, row = p >> 4, c16 = p & 15; *(u32x4*)(slot + (size_t)(16 * wid + row) * 128 + c16 * 8) = *(const u32x4*)(STG + (16 * wid + row) * HP + c16 * 8); }
    asm volatile("s_waitcnt lgkmcnt(0)\n\ts_barrier" ::: "memory");
}
__device__ __forceinline__ void h1_phase(unsigned char* lds, unsigned char* ws, bf16_t* SF, int G, int blk) {
    int tid_l = threadIdx.x; asm volatile("" : "+v"(tid_l)); const int tid = tid_l, lane = tid & 63, wid = __builtin_amdgcn_readfirstlane(tid >> 6), r = lane & 15, kq = lane >> 4;
    const bf16_t* Z = (const bf16_t*)(ws + WS_Z); bf16_t* VT = (bf16_t*)(lds + L_VT);
    for (int unit = blk; unit < 2048; unit += G) {
        const int b = unit >> 10, c = (unit >> 3) & 127, h = unit & 7, chain = b * 8 + h;
        const bf16_t* zrow = Z + ((size_t)h * M + (size_t)b * SEQ + c * 128 + 16 * wid + r) * 128;
        {
#pragma unroll
          for (int ks = 0; ks < 4; ++ks) { const u32x4 w = *(const u32x4*)(zrow + 3 * ZSEG + 8 * kq + 32 * ks);
#pragma unroll
              for (int e = 0; e < 4; ++e) { VT[(32 * ks + 8 * kq + 2 * e) * HP + 16 * wid + r] = (bf16_t)(w[e] & 0xffffu); VT[(32 * ks + 8 * kq + 2 * e + 1) * HP + 16 * wid + r] = (bf16_t)(w[e] >> 16); } } }
        h1_dir<0>(lds, zrow, h, SF + ((size_t)chain * 128 + c) * 16384, (float*)(ws + WS_DEC) + ((size_t)(0 * 16 + chain) * 128 + c) * 128);
        h1_dir<1>(lds, zrow, h, (bf16_t*)(ws + WS_SB) + ((size_t)chain * 128 + c) * 16384, (float*)(ws + WS_DEC) + ((size_t)(1 * 16 + chain) * 128 + c) * 128);
    }
}
__device__ __forceinline__ void h2_phase(unsigned char* ws, bf16_t* SF, int G, int blk) {
    int tid_l = threadIdx.x; asm volatile("" : "+v"(tid_l));
    const size_t gt = (size_t)blk * 512 + tid_l, GT = (size_t)G * 512;
    for (size_t w = gt; w < (size_t)32 * 4096; w += GT) {
        const int ch32 = (int)(w >> 12), dir = ch32 >> 4, chain = ch32 & 15, e4 = (int)(w & 4095);
        bf16_t* base = (dir ? (bf16_t*)(ws + WS_SB) : SF) + (size_t)chain * 128 * 16384 + (size_t)e4 * 4;
        const float* dbase = (const float*)(ws + WS_DEC) + ((size_t)(dir * 16 + chain) * 128) * 128 + ((e4 * 4) & 127);
        f32x4 S = {0.f, 0.f, 0.f, 0.f};
        for (int s0 = 0; s0 < 128; s0 += 8) {
            u32x2 raw[8]; f32x4 dd[8];
#pragma unroll
            for (int k = 0; k < 8; ++k) { const int c = dir ? 127 - (s0 + k) : (s0 + k); raw[k] = *(const u32x2*)(base + (size_t)c * 16384); dd[k] = *(const f32x4*)(dbase + (size_t)c * 128); }
#pragma unroll
            for (int k = 0; k < 8; ++k) { const int c = dir ? 127 - (s0 + k) : (s0 + k);
                u32x2 o; o.x = cvt_pk_bf16(S[0], S[1]); o.y = cvt_pk_bf16(S[2], S[3]); *(u32x2*)(base + (size_t)c * 16384) = o;
                const f32x4 ds = {bf_lo(raw[k].x), bf_hi(raw[k].x), bf_lo(raw[k].y), bf_hi(raw[k].y)}; S = dd[k] * S + ds; }
        }
    }
}
template <int DIR> __device__ __forceinline__ void h3_dir(unsigned char* lds, const bf16_t* zrow, int h, const bf16_t* slot, f32x4 (&o)[8]) {
    int tid_l = threadIdx.x; asm volatile("" : "+v"(tid_l)); const int tid = tid_l, lane = tid & 63, wid = __builtin_amdgcn_readfirstlane(tid >> 6), r = lane & 15, kq = lane >> 4;
    float* TOT = (float*)(lds + L_TOT); float* TOTE = (float*)(lds + L_TOTE); bf16_t* KO = (bf16_t*)(lds + L_KO); bf16_t* ST = (bf16_t*)(lds + L_ST); const bf16_t* VT = (const bf16_t*)(lds + L_VT); bf16_t* Pw = (bf16_t*)(lds + L_P) + wid * 16 * HP;
    float bl[32], qin[32]; bf16x8 kin[4];
    load32(zrow + (size_t)(1 + DIR) * ZSEG + 8 * kq, bl);
    load32(zrow + 8 * kq, qin);
    {
        float kk[32];
#pragma unroll
        for (int i = 0; i < 32; ++i) kk[i] = 1.0f - __builtin_amdgcn_exp2f(bl[i]);
        scan16x8<DIR>(bl); scan16x8<DIR>(bl + 8); scan16x8<DIR>(bl + 16); scan16x8<DIR>(bl + 24);
        float eb[32];
#pragma unroll
        for (int i = 0; i < 32; ++i) { eb[i] = __builtin_amdgcn_exp2f(bl[i]); qin[i] *= eb[i]; }
        if (r == (DIR ? 0 : 15)) {
#pragma unroll
            for (int ks = 0; ks < 4; ++ks) { *(f32x4*)(TOT + wid * 128 + 32 * ks + 8 * kq) = (f32x4){bl[8 * ks], bl[8 * ks + 1], bl[8 * ks + 2], bl[8 * ks + 3]}; *(f32x4*)(TOT + wid * 128 + 32 * ks + 8 * kq + 4) = (f32x4){bl[8 * ks + 4], bl[8 * ks + 5], bl[8 * ks + 6], bl[8 * ks + 7]}; }
#pragma unroll
            for (int ks = 0; ks < 4; ++ks) { *(f32x4*)(TOTE + wid * 128 + 32 * ks + 8 * kq) = (f32x4){eb[8 * ks], eb[8 * ks + 1], eb[8 * ks + 2], eb[8 * ks + 3]}; *(f32x4*)(TOTE + wid * 128 + 32 * ks + 8 * kq + 4) = (f32x4){eb[8 * ks + 4], eb[8 * ks + 5], eb[8 * ks + 6], eb[8 * ks + 7]}; }
        }
#pragma unroll
        for (int it = 0; it < 4; ++it) { const int p = tid + 512 * it, v = p >> 4, c16 = p & 15; *(u32x4*)(ST + v * HP + c16 * 8) = *(const u32x4*)(slot + (size_t)v * 128 + c16 * 8); }
#pragma unroll
        for (int it = 0; it < 4; ++it) { const int p = lane + 64 * it; *(u32x4*)(Pw + (p >> 4) * HP + (p & 15) * 8) = (u32x4){0u, 0u, 0u, 0u}; }
        __syncthreads();
        float tmp[8];
#pragma unroll
        for (int ks = 0; ks < 4; ++ks) {
            const f32x4 a = *(const f32x4*)(TOT + wid * 128 + 32 * ks + 8 * kq), b = *(const f32x4*)(TOT + wid * 128 + 32 * ks + 8 * kq + 4);
            const float tw[8] = {a[0], a[1], a[2], a[3], b[0], b[1], b[2], b[3]};
#pragma unroll
            for (int e = 0; e < 8; ++e) tmp[e] = kk[8 * ks + e] * __builtin_amdgcn_exp2f(tw[e] - bl[8 * ks + e]);
            *(bf16x8*)(KO + (16 * wid + r) * HP + 32 * ks + 8 * kq) = pk8(tmp);
#pragma unroll
            for (int e = 0; e < 8; ++e) tmp[e] = kk[8 * ks + e] * __builtin_amdgcn_exp2f(fminf(-bl[8 * ks + e], 115.f));
            kin[ks] = pk8(tmp);
        }
    }
    __syncthreads();
    {
        f32x4 sc = {0.f, 0.f, 0.f, 0.f};
#pragma unroll
        for (int ks = 0; ks < 4; ++ks) sc = __builtin_amdgcn_mfma_f32_16x16x32_bf16(pk8(qin + 8 * ks), kin[ks], sc, 0, 0, 0);
#pragma unroll
        for (int i = 0; i < 4; i += 2) { const int t = 4 * kq + i; const bool k0 = DIR ? (r >= t) : (r <= t), k1 = DIR ? (r >= t + 1) : (r <= t + 1); const unsigned w = cvt_pk_c(k0 ? sc[i] : 0.f, k1 ? sc[i + 1] : 0.f);
            Pw[t * HP + 16 * wid + r] = (bf16_t)(w & 0xffffu); Pw[(t + 1) * HP + 16 * wid + r] = (bf16_t)(w >> 16); }
    }
    float run[32];
#pragma unroll
    for (int i = 0; i < 32; ++i) run[i] = 1.f;
    for (int d = 1; d < 8; ++d) {
        const int m = DIR ? wid + d : wid - d;
        if (m < 0 || m > 7) break;
        f32x4 sc = {0.f, 0.f, 0.f, 0.f};
#pragma unroll
        for (int ks = 0; ks < 4; ++ks) {
            float tmp[8];
#pragma unroll
            for (int e = 0; e < 8; ++e) tmp[e] = qin[8 * ks + e] * run[8 * ks + e];
            const bf16x8 bb = *(const bf16x8*)(KO + (16 * m + r) * HP + 32 * ks + 8 * kq);
            sc = __builtin_amdgcn_mfma_f32_16x16x32_bf16(pk8(tmp), bb, sc, 0, 0, 0);
            const f32x4 a = *(const f32x4*)(TOTE + m * 128 + 32 * ks + 8 * kq), b = *(const f32x4*)(TOTE + m * 128 + 32 * ks + 8 * kq + 4);
            run[8 * ks] *= a[0]; run[8 * ks + 1] *= a[1]; run[8 * ks + 2] *= a[2]; run[8 * ks + 3] *= a[3]; run[8 * ks + 4] *= b[0]; run[8 * ks + 5] *= b[1]; run[8 * ks + 6] *= b[2]; run[8 * ks + 7] *= b[3];
        }
#pragma unroll
        for (int i = 0; i < 4; i += 2) { const unsigned w = cvt_pk_c(sc[i], sc[i + 1]); Pw[(4 * kq + i) * HP + 16 * m + r] = (bf16_t)(w & 0xffffu); Pw[(4 * kq + i + 1) * HP + 16 * m + r] = (bf16_t)(w >> 16); }
    }
#pragma unroll
    for (int i = 0; i < 32; ++i) qin[i] *= run[i];
    WAVE_LDS_FENCE();
#pragma unroll
    for (int ks = 0; ks < 4; ++ks) {
        const bf16x8 aq = pk8(qin + 8 * ks), ap = *(const bf16x8*)(Pw + r * HP + 32 * ks + 8 * kq);
#pragma unroll
        for (int nt = 0; nt < 8; ++nt) {
            o[nt] = __builtin_amdgcn_mfma_f32_16x16x32_bf16(aq, *(const bf16x8*)(ST + (16 * nt + r) * HP + 32 * ks + 8 * kq), o[nt], 0, 0, 0);
            o[nt] = __builtin_amdgcn_mfma_f32_16x16x32_bf16(ap, *(const bf16x8*)(VT + (16 * nt + r) * HP + 32 * ks + 8 * kq), o[nt], 0, 0, 0);
        }
    }
    __syncthreads();
}
template <bool STORE> __device__ __forceinline__ void h3_phase(unsigned char* lds, unsigned char* ws, const bf16_t* SF, const float* norm_g, int G, int blk) {
    int tid_l = threadIdx.x; asm volatile("" : "+v"(tid_l)); const int tid = tid_l, lane = tid & 63, wid = __builtin_amdgcn_readfirstlane(tid >> 6), r = lane & 15, kq = lane >> 4;
    bf16_t* Z = (bf16_t*)(ws + WS_Z); bf16_t* VT = (bf16_t*)(lds + L_VT); float* STGF = (float*)(lds + L_KO) + wid * 16 * 132;
    for (int unit = blk; unit < 2048; unit += G) {
        const int b = unit >> 10, c = (unit >> 3) & 127, h = unit & 7, chain = b * 8 + h;
        const size_t tok0 = (size_t)b * SEQ + c * 128 + 16 * wid;
        const bf16_t* zrow = Z + ((size_t)h * M + tok0 + r) * 128;
        {
#pragma unroll
          for (int ks = 0; ks < 4; ++ks) { const u32x4 w = *(const u32x4*)(zrow + 3 * ZSEG + 8 * kq + 32 * ks);
#pragma unroll
              for (int e = 0; e < 4; ++e) { VT[(32 * ks + 8 * kq + 2 * e) * HP + 16 * wid + r] = (bf16_t)(w[e] & 0xffffu); VT[(32 * ks + 8 * kq + 2 * e + 1) * HP + 16 * wid + r] = (bf16_t)(w[e] >> 16); } } }
        f32x4 o[8];
#pragma unroll
        for (int nt = 0; nt < 8; ++nt) o[nt] = (f32x4){0.f, 0.f, 0.f, 0.f};
        h3_dir<0>(lds, zrow, h, SF + ((size_t)chain * 128 + c) * 16384, o);
        h3_dir<1>(lds, zrow, h, (const bf16_t*)(ws + WS_SB) + ((size_t)chain * 128 + c) * 16384, o);
        float ssq[4];
#pragma unroll
        for (int i = 0; i < 4; ++i) { float s = 0.f;
#pragma unroll
            for (int nt = 0; nt < 8; ++nt) s += o[nt][i] * o[nt][i];
            s += __shfl_xor(s, 1); s += __shfl_xor(s, 2); s += __shfl_xor(s, 4); s += __shfl_xor(s, 8);
            ssq[i] = 1.0f / sqrtf(s * (1.0f / 128.0f) + LN_EPS); }
#pragma unroll
        for (int nt = 0; nt < 8; ++nt)
#pragma unroll
            for (int i = 0; i < 4; ++i) STGF[(4 * kq + i) * 132 + 16 * nt + r] = o[nt][i] * ssq[i];
        WAVE_LDS_FENCE();
#pragma unroll
        for (int it = 0; it < 4; ++it) {
            const int p = lane + 64 * it, row = p >> 4, c8 = p & 15;
            const f32x4 a = *(const f32x4*)(STGF + row * 132 + c8 * 8), bq = *(const f32x4*)(STGF + row * 132 + c8 * 8 + 4);
            const f32x4 g0 = *(const f32x4*)(norm_g + c8 * 8), g1 = *(const f32x4*)(norm_g + c8 * 8 + 4);
            bf16_t* zr = Z + ((size_t)h * M + tok0 + row) * 128 + c8 * 8;
            const u32x4 gw = *(const u32x4*)(zr + 4 * ZSEG);
            const f32x4 t0 = {bf_lo(gw.x), bf_hi(gw.x), bf_lo(gw.y), bf_hi(gw.y)}, t1 = {bf_lo(gw.z), bf_hi(gw.z), bf_lo(gw.w), bf_hi(gw.w)};
            if (STORE || a[0] == 123.456f) *(u32x4*)zr = pack8(a * g0 * t0, bq * g1 * t1);
        }
        asm volatile("s_waitcnt lgkmcnt(0)\n\ts_barrier" ::: "memory");
    }
}

#define LAS __attribute__((address_space(3)))
#define XB_TMO      128
#define XB_XCNT(j)  (256  + 64 * (j))
#define XB_XSUB(j)  (1280 + 64 * (j))
#define XB_XGEN(j)  (2304 + 64 * (j))
#define XB_TOP      3328
#define XB_TOPGEN   3392
#define XCD_BAR_WORDS 3456
#define XB_SPIN_CAP (1u << 18)

__device__ __forceinline__ unsigned xb_ld(unsigned* p)              { return __hip_atomic_load(p, __ATOMIC_RELAXED, __HIP_MEMORY_SCOPE_AGENT); }
__device__ __forceinline__ unsigned xb_add(unsigned* p, unsigned v) { return __hip_atomic_fetch_add(p, v, __ATOMIC_RELAXED, __HIP_MEMORY_SCOPE_AGENT); }
__device__ __forceinline__ unsigned xb_xcc_id() { return (unsigned)__builtin_amdgcn_s_getreg((3 << 11) | 20) & 0xFu; }
#define XB_SPIN(cond, bar) do { unsigned _sp = 0; while (cond) { __builtin_amdgcn_s_sleep(1); \
    if ((++_sp & 255u) == 0u) { if (xb_ld(&(bar)[XB_TMO])) break; if (_sp > XB_SPIN_CAP) { atomicAdd(&(bar)[XB_TMO], 1u); break; } } } } while (0)

struct XcdBarrier {
    unsigned* bar; unsigned x;
    volatile LAS unsigned* st;
};

__device__ __forceinline__ XcdBarrier xcd_barrier_post(unsigned* bar, volatile LAS unsigned* st) {
    XcdBarrier b; b.bar = bar; b.x = xb_xcc_id(); b.st = st;
    if (threadIdx.x == 0) (void)xb_add(&bar[XB_XCNT(b.x)], 1u);
    return b;
}
__device__ __forceinline__ void xcd_barrier_complete(unsigned* bar, unsigned x, unsigned& nloc, unsigned& nx) {
    const unsigned G = gridDim.x * gridDim.y * gridDim.z;
    unsigned sum, cnt, mine, sp = 0u;
    for (;;) {
        sum = 0u; cnt = 0u; mine = 0u;
#pragma unroll
        for (unsigned j = 0; j < 16; ++j) { const unsigned c = xb_ld(&bar[XB_XCNT(j)]); sum += c; cnt += (c > 0u) ? 1u : 0u; mine = (j == x) ? c : mine; }
        if (sum == G) break;
        __builtin_amdgcn_s_sleep(1);
        if ((++sp & 255u) == 0u) { if (xb_ld(&bar[XB_TMO])) break; if (sp > XB_SPIN_CAP) { atomicAdd(&bar[XB_TMO], 1u); break; } }
    }
    nloc = mine > 0u ? mine : 1u; nx = cnt > 0u ? cnt : 1u;
}

__device__ __forceinline__ void xcd_barrier(const XcdBarrier& b) {
    asm volatile("s_waitcnt vmcnt(0)" ::: "memory");
    __syncthreads();
    if (threadIdx.x == 0) {
        unsigned* bar = b.bar;
        __builtin_amdgcn_s_waitcnt(0);
        unsigned nloc = b.st[0], nx = b.st[1];
        if (nloc == 0u) { xcd_barrier_complete(bar, b.x, nloc, nx); b.st[0] = nloc; b.st[1] = nx; }
        const unsigned old = xb_add(&bar[XB_XSUB(b.x)], 1u);
        const unsigned gen = old / nloc;
        if (old + 1u == (gen + 1u) * nloc) {
            __builtin_amdgcn_fence(__ATOMIC_RELEASE, "agent");
            asm volatile("s_waitcnt vmcnt(0)" ::: "memory");
            const unsigned og = xb_add(&bar[XB_TOP], 1u);
            const unsigned tg = og / nx;
            if (og + 1u == (tg + 1u) * nx) xb_add(&bar[XB_TOPGEN], 1u);
            else XB_SPIN(xb_ld(&bar[XB_TOPGEN]) == tg, bar);
            __builtin_amdgcn_fence(__ATOMIC_ACQUIRE, "agent");
            xb_add(&bar[XB_XGEN(b.x)], 1u);
            asm volatile("s_waitcnt vmcnt(0)" ::: "memory");
        } else {
            XB_SPIN(xb_ld(&bar[XB_XGEN(b.x)]) == gen, bar);
            __builtin_amdgcn_fence(__ATOMIC_ACQUIRE, "agent");
            asm volatile("s_waitcnt vmcnt(0)" ::: "memory");
        }
    }
    __syncthreads();
}

#define GEMM_PHASE(EPI, Aptr, LDA, Bptr, LDB, NN, KK, Eobj) GEMM_PHASE_H(EPI, Aptr, LDA, 0, Bptr, LDB, NN, KK, Eobj)
#define GEMM_PHASE_H(EPI, Aptr, LDA, AHS, Bptr, LDB, NN, KK, Eobj) do { pg8::Gemm g_{(const bf16_t*)(Aptr), (const bf16_t*)(Bptr), M, (NN), (KK), (LDA), (LDB), (size_t)(AHS)}; pg8::StaticOrder S_; S_.init(M, (NN), G, blk); \
    pg8::gemm_phase<EPI, pg8::StaticOrder, true, true>((PG8_LAS unsigned char*)lds, g_, S_, (Eobj)); } while (0)

#define GSYNC() do { REP_SYNC(xcd_barrier(bar);) } while (0)
#define KPTR() KP kp = (KP)__builtin_amdgcn_kernarg_segment_ptr(); int G = gridDim.x, blk = blockIdx.x; asm volatile("" : "+s"(kp), "+s"(G), "+s"(blk)); unsigned char* ws = kp->ws; (void)ws
#define COMMA ,
template <int L> __device__ __forceinline__ void layer_fwd(unsigned char* lds, const XcdBarrier& bar) {
        constexpr int j = L >> 1; constexpr bool att = (L & 1) == 0;
        REP_WCONV({ KPTR(); wconv_phase(kp, L, lds, G, blk); })
        GSYNC();
        if (att) {
            { KPTR(); vec_finalize(ws, G, blk); EpiQKV E{(bf16_t*)(ws + WS_Q), (bf16_t*)(ws + WS_K), (bf16_t*)(ws + WS_V), (const float*)(ws + WS_ROPE)}; GEMM_PHASE(EpiQKV, ws + WS_XBX, D, ws + WS_WIN, D, NQKV, D, E); }
            GSYNC();
            REP_ATT({ KPTR(); attn_phase(lds, (const bf16_t*)(ws + WS_Q), (const bf16_t*)(ws + WS_K), (const bf16_t*)(ws + WS_V), (bf16_t*)(ws + WS_O), kp->att_sink + j * 16, G, blk); })
            GSYNC();
            { KPTR(); bf16_t* LOA = (bf16_t*)kp->out; using ER_ = EpiRes<false, L == 0>; ER_ E{kp->x, (const bf16_t*)(ws + WS_XBX), LOA, (bf16_t*)(ws + WS_XBX), LOA, (f32x2*)(ws + WS_ST1), nullptr, nullptr, nullptr}; GEMM_PHASE(ER_, ws + WS_O, D, ws + WS_WOUT, D, D, D, E); }
            GSYNC();
        } else {
            REP_HIN({ KPTR(); vec_finalize(ws, G, blk); EpiHin E{(bf16_t*)(ws + WS_Z), (const float*)(ws + WS_LB)}; GEMM_PHASE(EpiHin, ws + WS_XBX, D, ws + WS_WIN, D, HIN, D, E); })
            GSYNC();
            REP_H1({ KPTR(); h1_phase(lds, ws, (bf16_t*)kp->out + (size_t)M * D, G, blk); })
            GSYNC();
            { KPTR(); h2_phase(ws, (bf16_t*)kp->out + (size_t)M * D, G, blk); }
            GSYNC();
            REP_H3({ KPTR(); h3_phase<false>(lds, ws, (const bf16_t*)kp->out + (size_t)M * D, kp->hg_ng + j * 128, G, blk); })
            { KPTR(); h3_phase<true>(lds, ws, (const bf16_t*)kp->out + (size_t)M * D, kp->hg_ng + j * 128, G, blk); }
            GSYNC();
            { KPTR(); bf16_t* LOA = (bf16_t*)kp->out; using ER_ = EpiRes<false, false>; ER_ E{nullptr, (const bf16_t*)(ws + WS_XBX), LOA, (bf16_t*)(ws + WS_XBX), LOA, (f32x2*)(ws + WS_ST1), nullptr, nullptr, nullptr}; GEMM_PHASE_H(ER_, ws + WS_Z, 128, (size_t)M * 128 * 2, ws + WS_WOUT, D, D, D, E); }
            GSYNC();
        }
        REP_F1({ KPTR(); float* vec = (float*)(ws + WS_VEC); EpiFfn1 E{(bf16_t*)(ws + WS_H), (const f32x2*)(ws + WS_ST1), vec, vec + 5632}; GEMM_PHASE(EpiFfn1, ws + WS_XBX, D, ws + WS_W1, D, 2 * DFF, D, E); })
        { KPTR(); EpiPlain E{(bf16_t*)(ws + WS_PP), D}; GEMM_PHASE(EpiPlain, ws + WS_PB, PLE, ws + WS_WP, PLE, D, PLE, E); }
        GSYNC();
        { KPTR(); bf16_t* LOA = (bf16_t*)kp->out; bf16_t* LOW = (L == DEPTH - 1) ? (bf16_t*)(ws + WS_SB) : LOA;
          using ER_ = EpiRes<true, false>; ER_ E{nullptr, (const bf16_t*)(ws + WS_XBX), LOA, (bf16_t*)(ws + WS_XBY), LOW, (f32x2*)(ws + WS_ST2), (const f32x2*)(ws + WS_ST1), kp->lnm_g + L * D, kp->lnm_b + L * D}; GEMM_PHASE(ER_, ws + WS_H, DFF, ws + WS_W2, DFF, D, DFF, E); }
        GSYNC();
        { KPTR(); float* vec = (float*)(ws + WS_VEC); bf16_t* LOA = (bf16_t*)kp->out; const bf16_t* LOR = (L == DEPTH - 1) ? (const bf16_t*)(ws + WS_SB) : LOA;
          EpiPle<L == DEPTH - 1> E{kp->out, (const bf16_t*)(ws + WS_XBY), LOR, (bf16_t*)(ws + WS_XBX), LOA, (const f32x2*)(ws + WS_ST2), kp->lnf_g + L * D, kp->lnf_b + L * D, vec + 11264, vec + 12288, (const bf16_t*)(ws + WS_PP)}; GEMM_PHASE(EpiPle<L == DEPTH - 1>, ws + WS_XBY, D, ws + WS_WG, D, D, D, E); }
        GSYNC();
}
__global__ void __launch_bounds__(512, 2) mk_fwd(Ptrs Parg) {
    extern __shared__ __attribute__((aligned(16))) unsigned char lds[];
    cg::grid_group grid = cg::this_grid();
    volatile LAS unsigned* bst = (volatile LAS unsigned*)((LAS unsigned char*)lds + (LDS_BYTES - 16));
    if (threadIdx.x < 4) bst[threadIdx.x] = 0u;
    __syncthreads();
    XcdBarrier bar = xcd_barrier_post((unsigned*)(Parg.ws + WS_CTL), bst);
    grid.sync();
    layer_fwd<0>(lds, bar); layer_fwd<1>(lds, bar); layer_fwd<2>(lds, bar); layer_fwd<3>(lds, bar);
}

extern "C" void kernel_launch(void* const* d_in, const int* in_sizes, int n_in, void* d_out, int out_size, void* d_ws, size_t ws_size, hipStream_t stream) {
    static int grid = 0;
    if (grid == 0) {
        if (n_in != 17 || out_size != M * D || ws_size < WS_END) { fprintf(stderr, "kernel_launch: unexpected problem: n_in %d out %d ws %zu (need %zu)\n", n_in, out_size, ws_size, (size_t)WS_END); grid = -1; return; }
        int dev = 0, cus = 0, per_cu = 0;
        (void)hipGetDevice(&dev);
        (void)hipDeviceGetAttribute(&cus, hipDeviceAttributeMultiprocessorCount, dev);
        (void)hipFuncSetAttribute((const void*)mk_fwd, hipFuncAttributeMaxDynamicSharedMemorySize, LDS_BYTES);
        (void)hipOccupancyMaxActiveBlocksPerMultiprocessor(&per_cu, (const void*)mk_fwd, 512, LDS_BYTES);
        if (per_cu < 1) fprintf(stderr, "kernel_launch: occupancy query says %d blocks/CU\n", per_cu);
        (void)hipGetLastError();
        grid = cus;
    }
    if (grid < 0) return;
    (void)hipMemsetAsync((char*)d_ws + WS_CTL, 0, CTL_ZERO_BYTES, stream);
    Ptrs p{};
    p.x = (const float*)d_in[0]; p.p = (const float*)d_in[1]; p.att_wqkv = (const float*)d_in[2]; p.att_sink = (const float*)d_in[3]; p.att_wo = (const float*)d_in[4];
    p.hg_win = (const float*)d_in[5]; p.hg_lb = (const float*)d_in[6]; p.hg_ng = (const float*)d_in[7]; p.hg_wo = (const float*)d_in[8];
    p.lnm_g = (const float*)d_in[9]; p.lnm_b = (const float*)d_in[10]; p.ffn_win = (const float*)d_in[11]; p.ffn_wout = (const float*)d_in[12];
    p.lnf_g = (const float*)d_in[13]; p.lnf_b = (const float*)d_in[14]; p.ple_wg = (const float*)d_in[15]; p.ple_wp = (const float*)d_in[16];
    p.out = (float*)d_out; p.ws = (unsigned char*)d_ws;
    void* args[] = {&p};
    hipError_t e = hipLaunchCooperativeKernel((const void*)mk_fwd, dim3(grid), dim3(512), args, LDS_BYTES, stream);
    if (e != hipSuccess) fprintf(stderr, "kernel_launch: cooperative launch failed: %s (grid %d)\n", hipGetErrorString(e), grid);
}
```
